# Optimizing an MI355X kernel written in HIP

```python
import jax, jax.numpy as jnp
from jax import lax
import numpy as np

D_MODEL = 1024
BATCH = 4
SEQ = 4096
DEPTH = 1

CHUNK = 64
LEFT_CHUNKS = 8
BAND = (LEFT_CHUNKS + 1) * CHUNK
D_MIX = D_MODEL
D_ATTN = D_MIX // 2
HEAD_DIM = 64
N_HEADS = D_ATTN // HEAD_DIM
D_CONV = D_MIX - D_ATTN
CONV_GROUPS = 8
CONV_WIDTH = 31
MAX_REL = 128
D_FF = 2816
D_IN = 3 * D_ATTN + 2 * D_CONV
EPS = 1e-6
NEG_INF = -1e30

kernel_name = "hymba_conformer_chunk_attn_conv_block"


def rmsnorm(x, g):
    x32 = x.astype(jnp.float32)
    r = x32 * lax.rsqrt(jnp.mean(x32 * x32, axis=-1, keepdims=True) + EPS)
    return (r * g.astype(jnp.float32)).astype(x.dtype)


def layernorm(x, g, b):
    x32 = x.astype(jnp.float32)
    mu = jnp.mean(x32, axis=-1, keepdims=True)
    var = jnp.mean(jnp.square(x32 - mu), axis=-1, keepdims=True)
    r = (x32 - mu) * lax.rsqrt(var + EPS)
    return (r * g.astype(jnp.float32) + b.astype(jnp.float32)).astype(x.dtype)


def swiglu(h, w_gate, w_up, w_down):
    return (jax.nn.silu(h @ w_gate) * (h @ w_up)) @ w_down


def key_band(t, n_chunks):
    b, _, h, d = t.shape
    tc = t.reshape(b, n_chunks, CHUNK, h, d)
    tp = jnp.pad(tc, ((0, 0), (LEFT_CHUNKS, 0), (0, 0), (0, 0), (0, 0)))
    return jnp.concatenate([tp[:, j:j + n_chunks] for j in range(LEFT_CHUNKS + 1)], axis=2)


def chunk_band_attention(q, k, v, rel_bias):
    b, t, h, d = q.shape
    n_chunks = t // CHUNK
    qc = q.reshape(b, n_chunks, CHUNK, h, d)
    kb = key_band(k, n_chunks)
    vb = key_band(v, n_chunks)
    qi = jnp.arange(CHUNK)[:, None]
    kj = jnp.arange(BAND)[None, :]
    idx = jnp.clip(qi + LEFT_CHUNKS * CHUNK - kj, -MAX_REL, MAX_REL) + MAX_REL
    bias = jnp.transpose(rel_bias[idx], (2, 0, 1)).astype(jnp.float32)
    key_pos = (jnp.arange(n_chunks)[:, None] - LEFT_CHUNKS) * CHUNK + kj
    valid = key_pos >= 0
    scale = 1.0 / np.sqrt(HEAD_DIM)
    s = jnp.einsum('bcqhd,bckhd->bchqk', qc, kb).astype(jnp.float32) * scale
    s = s + bias[None, None]
    s = jnp.where(valid[None, :, None, None, :], s, NEG_INF)
    p = jax.nn.softmax(s, axis=-1).astype(v.dtype)
    o = jnp.einsum('bchqk,bckhd->bcqhd', p, vb)
    return o.reshape(b, t, h * d)


def conformer_conv(u, dw_kernel, dw_bias, ln_g, ln_b):
    g = u[..., :D_CONV] * jax.nn.sigmoid(u[..., D_CONV:])
    dw = lax.conv_general_dilated(
        g, dw_kernel[:, None, :].astype(g.dtype), window_strides=(1,),
        padding=[(CONV_WIDTH - 1, 0)],
        dimension_numbers=('NWC', 'WIO', 'NWC'),
        feature_group_count=D_CONV) + dw_bias
    return jax.nn.silu(layernorm(dw, ln_g, ln_b))


def setup_inputs(seed: int = 0) -> dict:
    key = jax.random.key(seed)
    ks = jax.random.split(key, 20)
    L = DEPTH
    f32 = jnp.float32

    def normal(k, shape, scale):
        return jax.random.normal(k, shape, f32) * scale

    def gain(k, shape):
        return 1.0 + 0.02 * jax.random.normal(k, shape, f32)

    return {
        "x": jax.random.normal(ks[0], (BATCH, SEQ, D_MODEL), f32),
        "ffn1_norm": gain(ks[1], (L, D_MODEL)),
        "ffn1_gate": normal(ks[2], (L, D_MODEL, D_FF), D_MODEL ** -0.5),
        "ffn1_up": normal(ks[3], (L, D_MODEL, D_FF), D_MODEL ** -0.5),
        "ffn1_down": normal(ks[4], (L, D_FF, D_MODEL), D_FF ** -0.5),
        "mix_norm": gain(ks[5], (L, D_MODEL)),
        "w_in": normal(ks[6], (L, D_MODEL, D_IN), D_MODEL ** -0.5),
        "rel_bias": normal(ks[7], (L, 2 * MAX_REL + 1, N_HEADS), 0.1),
        "dw_kernel": normal(ks[8], (L, CONV_WIDTH, D_CONV), CONV_WIDTH ** -0.5),
        "dw_bias": normal(ks[9], (L, D_CONV), 0.02),
        "conv_ln_g": gain(ks[10], (L, D_CONV)),
        "conv_ln_b": normal(ks[11], (L, D_CONV), 0.02),
        "w_out": normal(ks[12], (L, D_MIX, D_MODEL), D_MIX ** -0.5),
        "ffn2_norm": gain(ks[13], (L, D_MODEL)),
        "ffn2_gate": normal(ks[14], (L, D_MODEL, D_FF), D_MODEL ** -0.5),
        "ffn2_up": normal(ks[15], (L, D_MODEL, D_FF), D_MODEL ** -0.5),
        "ffn2_down": normal(ks[16], (L, D_FF, D_MODEL), D_FF ** -0.5),
        "final_norm": gain(ks[17], (D_MODEL,)),
    }


def reference(x, ffn1_norm, ffn1_gate, ffn1_up, ffn1_down, mix_norm, w_in, rel_bias,
              dw_kernel, dw_bias, conv_ln_g, conv_ln_b, w_out, ffn2_norm, ffn2_gate,
              ffn2_up, ffn2_down, final_norm):
    b, t, _ = x.shape
    for l in range(DEPTH):
        x = x + 0.5 * swiglu(rmsnorm(x, ffn1_norm[l]), ffn1_gate[l], ffn1_up[l], ffn1_down[l])
        z = rmsnorm(x, mix_norm[l]) @ w_in[l]
        q = z[..., 0 * D_ATTN:1 * D_ATTN].reshape(b, t, N_HEADS, HEAD_DIM)
        k = z[..., 1 * D_ATTN:2 * D_ATTN].reshape(b, t, N_HEADS, HEAD_DIM)
        v = z[..., 2 * D_ATTN:3 * D_ATTN].reshape(b, t, N_HEADS, HEAD_DIM)
        u = z[..., 3 * D_ATTN:]
        attn_out = chunk_band_attention(q, k, v, rel_bias[l])
        conv_out = conformer_conv(u, dw_kernel[l], dw_bias[l], conv_ln_g[l], conv_ln_b[l])
        x = x + jnp.concatenate([attn_out, conv_out], axis=-1) @ w_out[l]
        x = x + 0.5 * swiglu(rmsnorm(x, ffn2_norm[l]), ffn2_gate[l], ffn2_up[l], ffn2_down[l])
    return rmsnorm(x, final_norm)
```

```cpp
#include <hip/hip_runtime.h>
#include <hip/hip_cooperative_groups.h>
#include <cstdio>
#include <cstdint>
namespace cg = cooperative_groups;

namespace pg8 {
#define PG8_LAS __attribute__((address_space(3)))
typedef unsigned short bf16_t;
typedef short bf16x8 __attribute__((ext_vector_type(8)));
typedef float f32x4 __attribute__((ext_vector_type(4)));
typedef unsigned u32x4 __attribute__((ext_vector_type(4)));
typedef unsigned u32x2 __attribute__((ext_vector_type(2)));
constexpr int BM = 256, BK = 64, HALF = 128, HTB = HALF * BK * 2, STAGE_BYTES = 8 * HTB, NXCD = 8, WGM = 8;

__host__ __device__ __forceinline__ int lds_byte(int r, int c) { const int st = (r >> 4) * 2 + (c >> 5), rr = r & 15, cc = c & 31, ob = rr * 64 + cc * 2; return st * 1024 + (ob ^ (((ob >> 9) & 1) << 5)); }
__host__ __device__ __forceinline__ void stage_rc(int b, int& R, int& C) { const int st = b / 1024, sb = b % 1024, swz = sb ^ (((sb >> 9) & 1) << 5); R = (st >> 1) * 16 + swz / 64; C = (st & 1) * 32 + (swz % 64) / 2; }
__host__ __device__ __forceinline__ int perm32(int rho) { const int n = rho >> 4, i = rho & 15; return 8 * (i >> 2) + 4 * n + (i & 3); }

struct Unit { int pm, pn; };
struct Gemm { const bf16_t* A; const bf16_t* Bt; int M, N, K; };

struct StaticOrder {
    int nM, nN, nwg, G, c;
    __host__ __device__ void init(int M, int N, int G_, int c_) { nM = M / BM; nN = N / BM; nwg = nM * nN; G = G_; c = c_; }
    __host__ __device__ bool next(int i, Unit& u) const {
        const long L = (long)i * G + c; if (L >= nwg) return false;
        int wgid = (int)L; { const int q = nwg / NXCD, r = nwg % NXCD, xcd = wgid % NXCD, off = wgid / NXCD; wgid = (xcd < r ? xcd * (q + 1) : r * (q + 1) + (xcd - r) * q) + off; }
        const int nig = WGM * nN, gid = wgid / nig, fm = gid * WGM, gsz = (nM - fm) < WGM ? (nM - fm) : WGM;
        u.pm = fm + ((wgid % nig) % gsz); u.pn = (wgid % nig) / gsz; return true;
    }
    __device__ __forceinline__ void a_ready(const Unit&) const {}
    __device__ __forceinline__ void done(const Unit&) const {}
};

typedef float f32x2 __attribute__((ext_vector_type(2)));
typedef __bf16 bf16x2_t __attribute__((ext_vector_type(2)));
__device__ __forceinline__ unsigned cvt_pk_bf16(float lo, float hi) { f32x2 v = {lo, hi}; bf16x2_t b = __builtin_convertvector(v, bf16x2_t); return __builtin_bit_cast(unsigned, b); }
__device__ __forceinline__ float sigmoidf_fast(float v) { return __builtin_amdgcn_rcpf(1.0f + __builtin_amdgcn_exp2f(-1.4426950408889634f * v)); }

__device__ __forceinline__ float row_rstd(const float* ssq, int r) {
    const f32x4* p = (const f32x4*)(ssq + (size_t)r * 16);
    const f32x4 a = p[0], b = p[1], c = p[2], d = p[3];
    const float s = ((a[0] + a[1]) + (a[2] + a[3])) + ((b[0] + b[1]) + (b[2] + b[3])) + ((c[0] + c[1]) + (c[2] + c[3])) + ((d[0] + d[1]) + (d[2] + d[3]));
    return __builtin_amdgcn_rsqf(s * (1.0f / 1024.0f) + 1e-6f);
}

template <int KIND> struct EpiProj {
    static constexpr bool PERM = true, AFTER_DRAIN = false;
    bf16_t* Oplain; int split_cols; size_t split_stride; float scale0; int n_plain;
    bf16_t* Ogated; int ldg; const float* ssq; PG8_LAS float* rtab;
    static constexpr bool WANTS_NEXT = true;
    __device__ __forceinline__ void prefill(const Unit& u) const {
        const int t = threadIdx.x, rr = t >> 1, hf = t & 1; const f32x4* p = (const f32x4*)(ssq + (size_t)(u.pm * BM + rr) * 16 + hf * 8); const f32x4 a = p[0], b = p[1];
        float sm = ((a[0] + a[1]) + (a[2] + a[3])) + ((b[0] + b[1]) + (b[2] + b[3])); sm += __shfl_xor(sm, 1);
        if (hf == 0) rtab[rr] = __builtin_amdgcn_rsqf(sm * (1.0f / 1024.0f) + 1e-6f);
        asm volatile("s_waitcnt lgkmcnt(0)" ::: "memory"); __builtin_amdgcn_s_barrier(); asm volatile("" ::: "memory");
    }
    __device__ __forceinline__ void operator()(const f32x4 (&acc)[2][2][4][2], const Unit& u, int wr, int wc, int fr, int fq, bool has_next, const Unit& nxt, int ui) const {
        const int row0 = u.pm * BM + wr * 64 + fr;
        f32x4 na = {0.f, 0.f, 0.f, 0.f}, nb = {0.f, 0.f, 0.f, 0.f};
        const int trr = threadIdx.x >> 1, thf = threadIdx.x & 1;
        if (has_next) { const f32x4* p = (const f32x4*)(ssq + (size_t)(nxt.pm * BM + trr) * 16 + thf * 8); na = p[0]; nb = p[1]; }
        const PG8_LAS float* rloc = rtab + (ui & 1) * 256 + wr * 64 + fr;
        if (u.pn < n_plain) {
            int colt = u.pn * BM; const int t = colt / split_cols; bf16_t* base = Oplain + (size_t)t * split_stride; colt -= t * split_cols;
            const float sc = (t == 0) ? scale0 : 1.f; const int col0 = colt + wc * 32 + 8 * fq;
#pragma unroll
            for (int ai = 0; ai < 2; ++ai)
#pragma unroll
                for (int m = 0; m < 4; ++m) { const int r = row0 + ai * HALF + m * 16; const float rs = rloc[ai * HALF + m * 16] * sc; bf16_t* rowp = base + (size_t)r * split_cols + col0;
#pragma unroll
                    for (int bj = 0; bj < 2; ++bj) { const f32x4 v0 = acc[ai][bj][m][0] * rs, v1 = acc[ai][bj][m][1] * rs;
                        u32x4 w; w.x = cvt_pk_bf16(v0[0], v0[1]); w.y = cvt_pk_bf16(v0[2], v0[3]); w.z = cvt_pk_bf16(v1[0], v1[1]); w.w = cvt_pk_bf16(v1[2], v1[3]);
                        *(__attribute__((address_space(1))) u32x4*)(rowp + bj * HALF) = w; } }
        } else {
            const int col0 = (u.pn - n_plain) * HALF + wc * 32 + 8 * fq;
#pragma unroll
            for (int ai = 0; ai < 2; ++ai)
#pragma unroll
                for (int m = 0; m < 4; ++m) { const int r = row0 + ai * HALF + m * 16; const float rs = rloc[ai * HALF + m * 16];
                    float o[8];
                    const float kx = -1.4426950408889634f * rs, rs2 = rs * rs;
#pragma unroll
                    for (int n = 0; n < 2; ++n)
#pragma unroll
                        for (int e = 0; e < 4; ++e) { const float a = acc[ai][0][m][n][e], b = acc[ai][1][m][n][e];
                            if (KIND == 0) { const float sg = __builtin_amdgcn_rcpf(1.0f + __builtin_amdgcn_exp2f(a * kx)); o[n * 4 + e] = (a * b) * rs2 * sg; }
                            else { const float sg = __builtin_amdgcn_rcpf(1.0f + __builtin_amdgcn_exp2f(b * kx)); o[n * 4 + e] = (a * rs) * sg; } }
                    u32x4 w; w.x = cvt_pk_bf16(o[0], o[1]); w.y = cvt_pk_bf16(o[2], o[3]); w.z = cvt_pk_bf16(o[4], o[5]); w.w = cvt_pk_bf16(o[6], o[7]);
                    *(u32x4*)(Ogated + (size_t)r * ldg + col0) = w; }
        }
        if (has_next) { float sm = ((na[0] + na[1]) + (na[2] + na[3])) + ((nb[0] + nb[1]) + (nb[2] + nb[3])); sm += __shfl_xor(sm, 1);
            if (thf == 0) rtab[((ui + 1) & 1) * 256 + trr] = __builtin_amdgcn_rsqf(sm * (1.0f / 1024.0f) + 1e-6f); }
    }
};

__device__ __forceinline__ f32x4 bf4_to_f32(u32x2 w) { f32x4 r; r[0] = __builtin_bit_cast(float, w.x << 16); r[1] = __builtin_bit_cast(float, w.x & 0xffff0000u); r[2] = __builtin_bit_cast(float, w.y << 16); r[3] = __builtin_bit_cast(float, w.y & 0xffff0000u); return r; }
template <bool BASE_BF16, bool OUT_F32> struct EpiResid {
    static constexpr bool PERM = false, AFTER_DRAIN = false, WANTS_NEXT = false;
    const void* base; float* outf; bf16_t* outb; float* ssq_out; float alpha;
    __device__ __forceinline__ void operator()(const f32x4 (&acc)[2][2][4][2], const Unit& u, int wr, int wc, int fr, int fq) const {
        const int col0 = u.pn * BM + wc * 32 + 4 * fq; const int row0 = u.pm * BM + wr * 64 + fr;
        u32x2 bb[2][4][2][2];
        if constexpr (BASE_BF16) {
#pragma unroll
            for (int ai = 0; ai < 2; ++ai)
#pragma unroll
                for (int m = 0; m < 4; ++m)
#pragma unroll
                    for (int bj = 0; bj < 2; ++bj)
#pragma unroll
                        for (int n = 0; n < 2; ++n) bb[ai][m][bj][n] = *(const u32x2*)((const bf16_t*)base + (size_t)(row0 + ai * HALF + m * 16) * 1024 + col0 + bj * HALF + n * 16);
        }
#pragma unroll
        for (int ai = 0; ai < 2; ++ai) {
            f32x4 bf[4][2][2];
            if constexpr (!BASE_BF16) {
#pragma unroll
                for (int m = 0; m < 4; ++m)
#pragma unroll
                    for (int bj = 0; bj < 2; ++bj)
#pragma unroll
                        for (int n = 0; n < 2; ++n) bf[m][bj][n] = *(const f32x4*)((const float*)base + (size_t)(row0 + ai * HALF + m * 16) * 1024 + col0 + bj * HALF + n * 16);
            }
#pragma unroll
            for (int m = 0; m < 4; ++m) { const int r = row0 + ai * HALF + m * 16; const size_t off = (size_t)r * 1024 + col0; float s = 0.f;
#pragma unroll
                for (int bj = 0; bj < 2; ++bj)
#pragma unroll
                    for (int n = 0; n < 2; ++n) { f32x4 bs; if constexpr (BASE_BF16) bs = bf4_to_f32(bb[ai][m][bj][n]); else bs = bf[m][bj][n];
                        const f32x4 o = bs + acc[ai][bj][m][n] * alpha;
                        s += (o[0] * o[0] + o[1] * o[1]) + (o[2] * o[2] + o[3] * o[3]);
                        if constexpr (OUT_F32) *(f32x4*)(outf + off + bj * HALF + n * 16) = o;
                        else { u32x2 w; w.x = cvt_pk_bf16(o[0], o[1]); w.y = cvt_pk_bf16(o[2], o[3]); *(u32x2*)(outb + off + bj * HALF + n * 16) = w; } }
                s += __shfl_xor(s, 16); s += __shfl_xor(s, 32);
                if (fq == 0) ssq_out[(size_t)r * 16 + u.pn * 4 + wc] = s; }
        }
    }
};

template <bool BASE_BF16> struct EpiResidW {
    static constexpr bool PERM = true, AFTER_DRAIN = false, WANTS_NEXT = false;
    const void* base; bf16_t* outb; float* ssq_out; float alpha;
    __device__ __forceinline__ void operator()(const f32x4 (&acc)[2][2][4][2], const Unit& u, int wr, int wc, int fr, int fq) const {
        const int col0 = u.pn * BM + wc * 32 + 8 * fq; const int row0 = u.pm * BM + wr * 64 + fr;
        if constexpr (BASE_BF16) {
            u32x4 bb[2][4][2];
#pragma unroll
            for (int ai = 0; ai < 2; ++ai)
#pragma unroll
                for (int m = 0; m < 4; ++m)
#pragma unroll
                    for (int bj = 0; bj < 2; ++bj) bb[ai][m][bj] = *(const u32x4*)((const bf16_t*)base + (size_t)(row0 + ai * HALF + m * 16) * 1024 + col0 + bj * HALF);
#pragma unroll
            for (int ai = 0; ai < 2; ++ai)
#pragma unroll
                for (int m = 0; m < 4; ++m) { const int r = row0 + ai * HALF + m * 16; const size_t off = (size_t)r * 1024 + col0; float s = 0.f;
#pragma unroll
                    for (int bj = 0; bj < 2; ++bj) {
                        const f32x4 b0 = bf4_to_f32((u32x2){bb[ai][m][bj].x, bb[ai][m][bj].y}), b1 = bf4_to_f32((u32x2){bb[ai][m][bj].z, bb[ai][m][bj].w});
                        const f32x4 o0 = b0 + acc[ai][bj][m][0] * alpha, o1 = b1 + acc[ai][bj][m][1] * alpha;
                        s += ((o0[0] * o0[0] + o0[1] * o0[1]) + (o0[2] * o0[2] + o0[3] * o0[3])) + ((o1[0] * o1[0] + o1[1] * o1[1]) + (o1[2] * o1[2] + o1[3] * o1[3]));
                        u32x4 w; w.x = cvt_pk_bf16(o0[0], o0[1]); w.y = cvt_pk_bf16(o0[2], o0[3]); w.z = cvt_pk_bf16(o1[0], o1[1]); w.w = cvt_pk_bf16(o1[2], o1[3]);
                        *(u32x4*)(outb + off + bj * HALF) = w; }
                    s += __shfl_xor(s, 16); s += __shfl_xor(s, 32);
                    if (fq == 0) ssq_out[(size_t)r * 16 + u.pn * 4 + wc] = s; }
        } else {
            f32x4 cur[2][2][2], nx[2][2][2];
#define PG8_LDQ(dst, q) do { _Pragma("unroll") for (int mm = 0; mm < 2; ++mm) _Pragma("unroll") for (int bj = 0; bj < 2; ++bj) _Pragma("unroll") for (int n = 0; n < 2; ++n) \
                dst[mm][bj][n] = *(const f32x4*)((const float*)base + (size_t)(row0 + ((q) >> 1) * HALF + (((q) & 1) * 2 + mm) * 16) * 1024 + col0 + bj * HALF + n * 4); } while (0)
            PG8_LDQ(cur, 0);
#pragma unroll
            for (int q = 0; q < 4; ++q) {
                if (q < 3) PG8_LDQ(nx, q + 1);
                const int ai = q >> 1;
#pragma unroll
                for (int mm = 0; mm < 2; ++mm) { const int m = (q & 1) * 2 + mm; const int r = row0 + ai * HALF + m * 16; const size_t off = (size_t)r * 1024 + col0; float s = 0.f;
#pragma unroll
                    for (int bj = 0; bj < 2; ++bj) {
                        const f32x4 o0 = cur[mm][bj][0] + acc[ai][bj][m][0] * alpha, o1 = cur[mm][bj][1] + acc[ai][bj][m][1] * alpha;
                        s += ((o0[0] * o0[0] + o0[1] * o0[1]) + (o0[2] * o0[2] + o0[3] * o0[3])) + ((o1[0] * o1[0] + o1[1] * o1[1]) + (o1[2] * o1[2] + o1[3] * o1[3]));
                        u32x4 w; w.x = cvt_pk_bf16(o0[0], o0[1]); w.y = cvt_pk_bf16(o0[2], o0[3]); w.z = cvt_pk_bf16(o1[0], o1[1]); w.w = cvt_pk_bf16(o1[2], o1[3]);
                        *(u32x4*)(outb + off + bj * HALF) = w; }
                    s += __shfl_xor(s, 16); s += __shfl_xor(s, 32);
                    if (fq == 0) ssq_out[(size_t)r * 16 + u.pn * 4 + wc] = s; }
#pragma unroll
                for (int mm = 0; mm < 2; ++mm)
#pragma unroll
                    for (int bj = 0; bj < 2; ++bj)
#pragma unroll
                        for (int n = 0; n < 2; ++n) cur[mm][bj][n] = nx[mm][bj][n];
            }
#undef PG8_LDQ
        }
    }
};

struct EpiFinal {
    static constexpr bool PERM = true, AFTER_DRAIN = false, WANTS_NEXT = false;
    const bf16_t* base; float* out; float* ssq; unsigned* cnt; const float* gain; float alpha; PG8_LAS float* rtab;
    __device__ __forceinline__ void operator()(f32x4 (&acc)[2][2][4][2], const Unit& u, int wr, int wc, int fr, int fq) const {
        const int col0 = u.pn * BM + wc * 32 + 8 * fq; const int row0 = u.pm * BM + wr * 64 + fr;
        u32x4 bb[2][4][2];
#pragma unroll
        for (int ai = 0; ai < 2; ++ai)
#pragma unroll
            for (int m = 0; m < 4; ++m)
#pragma unroll
                for (int bj = 0; bj < 2; ++bj) bb[ai][m][bj] = *(const u32x4*)(base + (size_t)(row0 + ai * HALF + m * 16) * 1024 + col0 + bj * HALF);
#pragma unroll
        for (int ai = 0; ai < 2; ++ai)
#pragma unroll
            for (int m = 0; m < 4; ++m) { const int r = row0 + ai * HALF + m * 16; float s = 0.f;
#pragma unroll
                for (int bj = 0; bj < 2; ++bj)
#pragma unroll
                    for (int n = 0; n < 2; ++n) { const f32x4 o = bf4_to_f32(n ? (u32x2){bb[ai][m][bj].z, bb[ai][m][bj].w} : (u32x2){bb[ai][m][bj].x, bb[ai][m][bj].y}) + acc[ai][bj][m][n] * alpha; acc[ai][bj][m][n] = o;
                        s += (o[0] * o[0] + o[1] * o[1]) + (o[2] * o[2] + o[3] * o[3]); }
                s += __shfl_xor(s, 16); s += __shfl_xor(s, 32);
                if (fq == 0) __hip_atomic_store(ssq + (size_t)r * 16 + u.pn * 4 + wc, s, __ATOMIC_RELAXED, __HIP_MEMORY_SCOPE_AGENT); }
        asm volatile("s_waitcnt vmcnt(0)" ::: "memory");
        unsigned* c = cnt + 64 * u.pm;
        if ((threadIdx.x & 63) == 0) __hip_atomic_fetch_add(c, 1u, __ATOMIC_RELAXED, __HIP_MEMORY_SCOPE_AGENT);
        if (__builtin_amdgcn_readfirstlane(threadIdx.x >> 6) == 0) {
            unsigned spins = 0;
            while ((unsigned)__builtin_amdgcn_readfirstlane(__hip_atomic_load(c, __ATOMIC_RELAXED, __HIP_MEMORY_SCOPE_AGENT)) < 32u) { __builtin_amdgcn_s_sleep(2); if (++spins > (1u << 22)) break; }
            __builtin_amdgcn_fence(__ATOMIC_ACQUIRE, "agent"); asm volatile("s_waitcnt vmcnt(0)" ::: "memory");
        }
        __builtin_amdgcn_s_barrier(); asm volatile("" ::: "memory");
        { const int t = threadIdx.x, rr = t >> 1, hf = t & 1; const f32x4* p = (const f32x4*)(ssq + (size_t)(u.pm * BM + rr) * 16 + hf * 8); const f32x4 a = p[0], b = p[1];
          float sm = ((a[0] + a[1]) + (a[2] + a[3])) + ((b[0] + b[1]) + (b[2] + b[3])); sm += __shfl_xor(sm, 1);
          if (hf == 0) rtab[rr] = __builtin_amdgcn_rsqf(sm * (1.0f / 1024.0f) + 1e-6f);
          asm volatile("s_waitcnt lgkmcnt(0)" ::: "memory"); __builtin_amdgcn_s_barrier(); asm volatile("" ::: "memory"); }
        const PG8_LAS float* rloc = rtab + wr * 64 + fr;
        f32x4 gv[2][2];
#pragma unroll
        for (int bj = 0; bj < 2; ++bj)
#pragma unroll
            for (int n = 0; n < 2; ++n) gv[bj][n] = *(const f32x4*)(gain + col0 + bj * HALF + n * 4);
#pragma unroll
        for (int ai = 0; ai < 2; ++ai)
#pragma unroll
            for (int m = 0; m < 4; ++m) { const int r = row0 + ai * HALF + m * 16; const float rs = rloc[ai * HALF + m * 16]; const size_t off = (size_t)r * 1024 + col0;
#pragma unroll
                for (int bj = 0; bj < 2; ++bj)
#pragma unroll
                    for (int n = 0; n < 2; ++n) *(f32x4*)(out + off + bj * HALF + n * 4) = acc[ai][bj][m][n] * rs * gv[bj][n]; }
    }
};

template <class Epi, class Sched, bool ALIGN_EPI = false, bool SP2 = false>
__device__ __forceinline__ void gemm_phase(PG8_LAS unsigned char* lds, const Gemm g, const Sched& S, const Epi& E) {
    const int tid = threadIdx.x, wid = __builtin_amdgcn_readfirstlane(tid >> 6), lane = tid & 63, wr = wid >> 2, wc = wid & 3, fr = lane & 15, fq = lane >> 4;
    const int K = g.K, nt = K / BK;
    unsigned voffA[2], voffB[2];
#pragma unroll
    for (int i = 0; i < 2; ++i) { int R, C; stage_rc(tid * 16 + i * 8192, R, C); const int Rb = Epi::PERM ? ((R & ~31) + perm32(R & 31)) : R;
        voffA[i] = (unsigned)(R * K + C) * 2u; voffB[i] = (unsigned)(Rb * K + C) * 2u; }
    const size_t kstep = (size_t)(BK * 2);
    const size_t hstep = (size_t)HALF * K * 2;
    const size_t tstep = 2 * hstep;
    const unsigned ldsw = (unsigned)wid * 1024u;
    const int aoff = lds_byte(wr * 64 + fr, fq * 8), boff = lds_byte(wc * 32 + fr, fq * 8);
#define PG8_SA(b, h) (((b) * 2 + (h)) * HTB)
#define PG8_SB(b, h) ((4 + (b) * 2 + (h)) * HTB)
#define PG8_STAGE(bufoff, gbase, voff) do { _Pragma("unroll") for (int _i = 0; _i < 2; ++_i) \
        __builtin_amdgcn_global_load_lds((const unsigned*)((const char*)(gbase) + (voff)[_i]), (PG8_LAS unsigned*)(lds + (bufoff) + ldsw + _i * 8192), 16, 0, 0); } while (0)
#define PG8_LDA(dst, b, h) do { _Pragma("unroll") for (int m = 0; m < 4; ++m) _Pragma("unroll") for (int k = 0; k < 2; ++k) dst[m][k] = *(const PG8_LAS bf16x8*)(lds + PG8_SA(b, h) + aoff + m * 2048 + k * 1024); } while (0)
#define PG8_LDB(dst, b, h) do { _Pragma("unroll") for (int n = 0; n < 2; ++n) _Pragma("unroll") for (int k = 0; k < 2; ++k) dst[n][k] = *(const PG8_LAS bf16x8*)(lds + PG8_SB(b, h) + boff + n * 2048 + k * 1024); } while (0)
#define PG8_MMA(ai, bj, At, Bt) do { __builtin_amdgcn_s_setprio(1); _Pragma("unroll") for (int m = 0; m < 4; ++m) _Pragma("unroll") for (int n = 0; n < 2; ++n) _Pragma("unroll") for (int k = 0; k < 2; ++k) \
        acc[ai][bj][m][n] = __builtin_amdgcn_mfma_f32_16x16x32_bf16(Bt[n][k], At[m][k], acc[ai][bj][m][n], 0, 0, 0); __builtin_amdgcn_s_setprio(0); } while (0)
#define PG8_WAIT_V(n) asm volatile("s_waitcnt vmcnt(" #n ")" ::: "memory")
#define PG8_WAIT_L(n) asm volatile("s_waitcnt lgkmcnt(" #n ")" ::: "memory")
#define PG8_BAR __builtin_amdgcn_s_barrier()
#define PG8_SCHED __builtin_amdgcn_sched_barrier(0)
    Unit cur, nxt; int ui = 0;
    if (!S.next(0, cur)) return;
    if constexpr (Epi::WANTS_NEXT) E.prefill(cur);
    f32x4 acc[2][2][4][2];
#pragma unroll
    for (int a = 0; a < 2; ++a)
#pragma unroll
        for (int b = 0; b < 2; ++b)
#pragma unroll
            for (int m = 0; m < 4; ++m)
#pragma unroll
                for (int n = 0; n < 2; ++n) acc[a][b][m][n] = (f32x4){0.f, 0.f, 0.f, 0.f};
    bf16x8 At[4][2], B0[2][2], B1[2][2];
    const char* cA = (const char*)g.A + (size_t)cur.pm * tstep; const char* cB = (const char*)g.Bt + (size_t)cur.pn * tstep;
    S.a_ready(cur);
    if constexpr (SP2) {
        PG8_STAGE(PG8_SB(0, 0), cB, voffB); PG8_STAGE(PG8_SB(0, 1), cB + hstep, voffB); PG8_STAGE(PG8_SA(0, 0), cA, voffA); PG8_STAGE(PG8_SA(0, 1), cA + hstep, voffA);
        if (wr == 1) PG8_BAR;
        PG8_WAIT_V(2); PG8_BAR;
        PG8_STAGE(PG8_SB(1, 0), cB + kstep, voffB); PG8_STAGE(PG8_SA(1, 0), cA + kstep, voffA); PG8_STAGE(PG8_SB(1, 1), cB + hstep + kstep, voffB);
        PG8_WAIT_V(6); PG8_BAR;
    } else {
        PG8_STAGE(PG8_SB(0, 0), cB, voffB); PG8_STAGE(PG8_SA(0, 0), cA, voffA); PG8_STAGE(PG8_SB(0, 1), cB + hstep, voffB); PG8_STAGE(PG8_SA(0, 1), cA + hstep, voffA);
        if (wr == 1) PG8_BAR;
        PG8_WAIT_V(4); PG8_BAR;
        PG8_STAGE(PG8_SB(1, 0), cB + kstep, voffB); PG8_STAGE(PG8_SA(1, 0), cA + kstep, voffA); PG8_STAGE(PG8_SB(1, 1), cB + hstep + kstep, voffB);
        PG8_WAIT_V(6); PG8_BAR;
    }
    for (;;) {
        const bool has_next = S.next(ui + 1, nxt);
        const char* nA = has_next ? (const char*)g.A + (size_t)nxt.pm * tstep : cA; const char* nB = has_next ? (const char*)g.Bt + (size_t)nxt.pn * tstep : cB;
        for (int t = 0; t < nt; t += 2) {
            const bool last = (t == nt - 2);
            const char* a1 = cA + (size_t)(t + 1) * kstep;
            const char* a2 = last ? nA : cA + (size_t)(t + 2) * kstep; const char* b2 = last ? nB : cB + (size_t)(t + 2) * kstep;
            const char* a3 = a2 + kstep; const char* b3 = b2 + kstep;
            if (last && has_next) S.a_ready(nxt);
            if constexpr (SP2) {
            PG8_LDB(B0, 0, 0); PG8_LDB(B1, 0, 1); PG8_SCHED; PG8_LDA(At, 0, 0); PG8_STAGE(PG8_SA(1, 1), a1 + hstep, voffA);
            PG8_WAIT_V(8); PG8_WAIT_L(0); PG8_BAR; PG8_MMA(0, 0, At, B0); PG8_MMA(0, 1, At, B1); PG8_BAR; PG8_SCHED;
            PG8_LDA(At, 0, 1); PG8_STAGE(PG8_SB(0, 0), b2, voffB); PG8_STAGE(PG8_SB(0, 1), b2 + hstep, voffB); PG8_STAGE(PG8_SA(0, 0), a2, voffA);
            PG8_WAIT_V(8); PG8_WAIT_L(0); PG8_BAR; PG8_MMA(1, 0, At, B0); PG8_MMA(1, 1, At, B1); PG8_BAR; PG8_SCHED;
            PG8_LDB(B0, 1, 0); PG8_LDB(B1, 1, 1); PG8_SCHED; PG8_LDA(At, 1, 0); PG8_STAGE(PG8_SA(0, 1), a2 + hstep, voffA);
            PG8_WAIT_V(8); PG8_WAIT_L(0); PG8_BAR; PG8_MMA(0, 0, At, B0); PG8_MMA(0, 1, At, B1); PG8_BAR; PG8_SCHED;
            PG8_LDA(At, 1, 1); PG8_STAGE(PG8_SB(1, 0), b3, voffB); PG8_STAGE(PG8_SB(1, 1), b3 + hstep, voffB); PG8_STAGE(PG8_SA(1, 0), a3, voffA);
            PG8_WAIT_V(8); PG8_WAIT_L(0); PG8_BAR; PG8_MMA(1, 0, At, B0); PG8_MMA(1, 1, At, B1); PG8_BAR; PG8_SCHED;
            } else {
            PG8_LDB(B0, 0, 0); PG8_SCHED; PG8_LDA(At, 0, 0); PG8_STAGE(PG8_SA(1, 1), a1 + hstep, voffA);
            PG8_WAIT_L(8); PG8_BAR; PG8_WAIT_L(0); PG8_MMA(0, 0, At, B0); PG8_BAR; PG8_SCHED;
            PG8_LDB(B1, 0, 1); PG8_STAGE(PG8_SB(0, 0), b2, voffB);
            PG8_BAR; PG8_WAIT_L(0); PG8_MMA(0, 1, At, B1); PG8_BAR;
            PG8_LDA(At, 0, 1); PG8_STAGE(PG8_SA(0, 0), a2, voffA);
            PG8_BAR; PG8_WAIT_L(0); PG8_MMA(1, 0, At, B0); PG8_BAR; PG8_SCHED;
            PG8_STAGE(PG8_SB(0, 1), b2 + hstep, voffB);
            PG8_WAIT_V(6); PG8_BAR; PG8_MMA(1, 1, At, B1); PG8_BAR;
            PG8_LDB(B0, 1, 0); PG8_SCHED; PG8_LDA(At, 1, 0); PG8_STAGE(PG8_SA(0, 1), a2 + hstep, voffA);
            PG8_WAIT_L(8); PG8_BAR; PG8_WAIT_L(0); PG8_MMA(0, 0, At, B0); PG8_BAR; PG8_SCHED;
            PG8_LDB(B1, 1, 1); PG8_STAGE(PG8_SB(1, 0), b3, voffB);
            PG8_BAR; PG8_WAIT_L(0); PG8_MMA(0, 1, At, B1); PG8_BAR;
            PG8_LDA(At, 1, 1); PG8_STAGE(PG8_SA(1, 0), a3, voffA);
            PG8_BAR; PG8_WAIT_L(0); PG8_MMA(1, 0, At, B0); PG8_BAR; PG8_SCHED;
            PG8_STAGE(PG8_SB(1, 1), b3 + hstep, voffB);
            PG8_WAIT_V(6); PG8_BAR; PG8_MMA(1, 1, At, B1); PG8_BAR;
            }
        }
        if constexpr (ALIGN_EPI) { if (wr == 0) PG8_BAR; }
        if constexpr (!Epi::AFTER_DRAIN) { if constexpr (Epi::WANTS_NEXT) E(acc, cur, wr, wc, fr, fq, has_next, nxt, ui); else E(acc, cur, wr, wc, fr, fq); S.done(cur); }
        if (!has_next) break;
#pragma unroll
        for (int a = 0; a < 2; ++a)
#pragma unroll
            for (int b = 0; b < 2; ++b)
#pragma unroll
                for (int m = 0; m < 4; ++m)
#pragma unroll
                    for (int n = 0; n < 2; ++n) acc[a][b][m][n] = (f32x4){0.f, 0.f, 0.f, 0.f};
        cur = nxt; cA = nA; cB = nB; ++ui;
        if constexpr (ALIGN_EPI) { if (wr == 1) PG8_BAR; }
    }
    PG8_WAIT_V(0);
    if constexpr (!ALIGN_EPI) { if (wr == 0) PG8_BAR; }
    PG8_BAR;
#undef PG8_SA
#undef PG8_SB
#undef PG8_STAGE
#undef PG8_LDA
#undef PG8_LDB
#undef PG8_MMA
#undef PG8_WAIT_V
#undef PG8_WAIT_L
#undef PG8_BAR
#undef PG8_SCHED
}
}

#define LAS __attribute__((address_space(3)))
typedef unsigned short bf16;
typedef unsigned u32x4 __attribute__((ext_vector_type(4)));
typedef float f32x4 __attribute__((ext_vector_type(4)));
typedef float f32x16 __attribute__((ext_vector_type(16)));
typedef short bf16x8 __attribute__((ext_vector_type(8)));
typedef short s16x4 __attribute__((ext_vector_type(4)));

constexpr int M = 16384, D = 1024, FF = 2816, DIN = 2560, SEQ = 4096, NHEAD = 8, DA = 512, DC = 512;
constexpr int NWAVES = 8;
constexpr size_t MiB = 1u << 20;
constexpr size_t WS_SSQ0 = 1 * MiB, WS_SSQ1 = 2 * MiB, WS_SSQ2 = 3 * MiB, WS_SSQ3 = 4 * MiB;
constexpr size_t WS_WGU1 = 6 * MiB, WS_WD1 = 17 * MiB, WS_WIN = 23 * MiB, WS_WOUT = 28 * MiB, WS_WGU2 = 30 * MiB, WS_WD2 = 41 * MiB;
constexpr size_t WS_XB = 48 * MiB, WS_AC = 80 * MiB, WS_H = 144 * MiB, WS_END = 232 * MiB;
constexpr size_t QKVG_STRIDE = 16 * MiB;
constexpr int LDS_BYTES = 147456;
constexpr float LOG2E = 1.4426950408889634f;
constexpr float QSCALE = 0.125f * LOG2E;

__device__ __forceinline__ unsigned f2bf(float f) { unsigned u = __builtin_bit_cast(unsigned, f); return (u + 0x7fffu + ((u >> 16) & 1u)) >> 16; }
__device__ __forceinline__ unsigned pk2(float lo, float hi) { return pg8::cvt_pk_bf16(lo, hi); }
__device__ __forceinline__ float bf2f(unsigned short b) { return __builtin_bit_cast(float, (unsigned)b << 16); }
__device__ __forceinline__ float wave_sum(float v) {
#pragma unroll
    for (int o = 1; o < 64; o <<= 1) v += __shfl_xor(v, o);
    return v;
}

__device__ __forceinline__ void p0_transpose_item(const float* W, int K, int N, bf16* WT, const float* gain, int k0, int n0, int dest_row0, LAS float* scr, int lane, bool wt = false) {
    const int kr = lane >> 3, nq = lane & 7;
    f32x4 v[8]; float gk[8];
#pragma unroll
    for (int i = 0; i < 8; ++i) { const int kk = 8 * i + kr; v[i] = *(const f32x4*)(W + (size_t)(k0 + kk) * N + n0 + 4 * nq); gk[i] = gain ? gain[k0 + kk] : 1.f; }
#pragma unroll
    for (int i = 0; i < 8; ++i) { LAS float* d = scr + (8 * i + kr) * 33 + 4 * nq; d[0] = v[i].x * gk[i]; d[1] = v[i].y * gk[i]; d[2] = v[i].z * gk[i]; d[3] = v[i].w * gk[i]; }
    const int c = lane & 7;
#pragma unroll
    for (int j = 0; j < 4; ++j) { const int n = (lane >> 3) + 8 * j; const LAS float* s = scr + (8 * c) * 33 + n;
        u32x4 o; o.x = pk2(s[0 * 33], s[1 * 33]); o.y = pk2(s[2 * 33], s[3 * 33]); o.z = pk2(s[4 * 33], s[5 * 33]); o.w = pk2(s[6 * 33], s[7 * 33]);
        bf16* op = WT + (size_t)(dest_row0 + n) * K + k0 + 8 * c;
        if (wt) asm volatile("global_store_dwordx4 %0, %1, off sc1" :: "v"(op), "v"(o) : "memory");
        else *(u32x4*)op = o; }
}
__device__ __forceinline__ int gu_row(int n0, int second) { return (n0 >> 7) * 256 + (n0 & 127) + second * 128; }

struct Ptrs {
    const float *x, *n1, *g1, *u1, *d1, *nm, *win, *relb, *dwk, *dwb, *lng, *lnb, *wout, *n2, *g2, *u2, *d2, *nf;
    float* out; unsigned char* ws;
};

__device__ __forceinline__ void convert_weights(const Ptrs& P, LAS unsigned char* lds, int set, int gw, int NGW, int wave, int lane, bool wt = false) {
    LAS float* scr = (LAS float*)(lds + wave * 16384);
    constexpr int I_GU = (D / 64) * (FF / 32), I_DN = (FF / 64) * (D / 32), I_IN = (D / 64) * (DIN / 32), I_OUT = (D / 64) * (D / 32);
    const int nitems = set == 0 ? 2 * I_GU : set == 1 ? I_DN + I_IN : I_OUT + 2 * I_GU + I_DN;
    for (int it = gw; it < nitems; it += NGW) {
        int r = it;
        if (set == 1) {
            if (r < I_DN) { const int nblk = D / 32, kb = r / nblk, nb = r % nblk;
                p0_transpose_item(P.d1, FF, D, (bf16*)(P.ws + WS_WD1), nullptr, 64 * kb, 32 * nb, 32 * nb, scr, lane, wt); continue; }
            r -= I_DN;
            { const int nblk = DIN / 32, kb = r / nblk, nb = r % nblk, n0 = 32 * nb;
                int drow = n0;
                if (n0 >= 3 * DA) { const int c = (n0 - 3 * DA) & (DC - 1), second = (n0 - 3 * DA) >> 9; drow = 3 * DA + gu_row(c, second); }
                p0_transpose_item(P.win, D, DIN, (bf16*)(P.ws + WS_WIN), P.nm, 64 * kb, n0, drow, scr, lane, wt); continue; }
        }
        if (set == 2) {
            if (r < I_OUT) { const int nblk = D / 32, kb = r / nblk, nb = r % nblk;
                p0_transpose_item(P.wout, D, D, (bf16*)(P.ws + WS_WOUT), nullptr, 64 * kb, 32 * nb, 32 * nb, scr, lane, wt); continue; }
            r -= I_OUT;
            if (r >= 2 * I_GU) { r -= 2 * I_GU; const int nblk = D / 32, kb = r / nblk, nb = r % nblk;
                p0_transpose_item(P.d2, FF, D, (bf16*)(P.ws + WS_WD2), nullptr, 64 * kb, 32 * nb, 32 * nb, scr, lane, wt); continue; }
        }
        {
            const int second = r / I_GU; r -= second * I_GU; const int nblk = FF / 32, kb = r / nblk, nb = r % nblk;
            const float* W = set == 0 ? (second ? P.u1 : P.g1) : (second ? P.u2 : P.g2);
            p0_transpose_item(W, D, FF, (bf16*)(P.ws + (set == 0 ? WS_WGU1 : WS_WGU2)), set == 0 ? P.n1 : P.n2, 64 * kb, 32 * nb, gu_row(32 * nb, second), scr, lane, wt); }
    }
}
__device__ __forceinline__ void p0_prologue(const Ptrs& P, LAS unsigned char* lds, int gw, int NGW, int wave, int lane, bool all_sets) {
    convert_weights(P, lds, 0, gw, NGW, wave, lane);
    if (all_sets) { convert_weights(P, lds, 1, gw, NGW, wave, lane); convert_weights(P, lds, 2, gw, NGW, wave, lane); }
    bf16* XB = (bf16*)(P.ws + WS_XB); float* ssq0 = (float*)(P.ws + WS_SSQ0);
    for (int m = gw; m < M; m += 2 * NGW) {
        const int m1 = m + NGW;
        const bool has1 = m1 < M; const int mm1 = has1 ? m1 : m;
        const f32x4* xr0 = (const f32x4*)(P.x + (size_t)m * D) + lane; const f32x4* xr1 = (const f32x4*)(P.x + (size_t)mm1 * D) + lane;
        f32x4 v0[4], v1[4]; float s0 = 0.f, s1 = 0.f;
#pragma unroll
        for (int j = 0; j < 4; ++j) { v0[j] = xr0[64 * j]; v1[j] = xr1[64 * j]; }
#pragma unroll
        for (int j = 0; j < 4; ++j) { s0 += (v0[j].x * v0[j].x + v0[j].y * v0[j].y) + (v0[j].z * v0[j].z + v0[j].w * v0[j].w); s1 += (v1[j].x * v1[j].x + v1[j].y * v1[j].y) + (v1[j].z * v1[j].z + v1[j].w * v1[j].w); }
        s0 = wave_sum(s0); s1 = wave_sum(s1);
        unsigned long long* o0 = (unsigned long long*)(XB + (size_t)m * D) + lane; unsigned long long* o1 = (unsigned long long*)(XB + (size_t)mm1 * D) + lane;
#pragma unroll
        for (int j = 0; j < 4; ++j) { o0[64 * j] = (unsigned long long)pk2(v0[j].x, v0[j].y) | ((unsigned long long)pk2(v0[j].z, v0[j].w) << 32);
            if (has1) o1[64 * j] = (unsigned long long)pk2(v1[j].x, v1[j].y) | ((unsigned long long)pk2(v1[j].z, v1[j].w) << 32); }
        if (lane < 16) { ssq0[(size_t)m * 16 + lane] = (lane == 0) ? s0 : 0.f; if (has1) ssq0[(size_t)m1 * 16 + lane] = (lane == 0) ? s1 : 0.f; }
    }
}

__device__ __forceinline__ int crow(int r, int hi) { return (r & 3) + 8 * (r >> 2) + 4 * hi; }
typedef short v4i16_t __attribute__((ext_vector_type(4)));
__device__ __forceinline__ s16x4 vtr(const LAS unsigned char* p) { return __builtin_bit_cast(s16x4, __builtin_amdgcn_ds_read_tr16_b64_v4i16((LAS v4i16_t*)p)); }

constexpr int AT_K = 0, AT_V = 16384, AT_WS = 32768, AT_TBL = 34816, AT_OST = 38912, AT_BYTES = AT_OST + NWAVES * 4096;

__device__ __forceinline__ void attn_unit(int b, int h, int grp, const bf16* Q, const bf16* K, const bf16* V, bf16* AC, const float* relb, LAS unsigned char* shm) {
    const int tid = threadIdx.x, lane = tid & 63, r32 = lane & 31, hi = lane >> 5; const int wid = __builtin_amdgcn_readfirstlane(tid >> 6);
    const size_t rowbase = (size_t)b * SEQ;
    const int cq = 4 * grp + (wid >> 1), qi0 = (wid & 1) * 32;
    const size_t qrow0 = rowbase + (size_t)cq * 64 + qi0;
    bf16x8 qr[4];
#pragma unroll
    for (int d0 = 0; d0 < 4; ++d0) qr[d0] = *(const bf16x8*)(Q + (qrow0 + r32) * DA + h * 64 + d0 * 16 + hi * 8);
    LAS float* tbl = (LAS float*)(shm + AT_TBL);
    for (int j = tid; j < 639; j += NWAVES * 64) { const int d = 575 - j; const int idx = (d < 128 ? d : 128) + 128; tbl[j] = relb[idx * NHEAD + h] * LOG2E; }
    LAS float* wsf = (LAS float*)(shm + AT_WS) + wid * 64;
    const int kt_lo = (4 * grp - 8) > 0 ? (4 * grp - 8) : 0, kt_hi = 4 * grp + 3;
    const bf16* ksrc = K + (rowbase + lane) * DA + h * 64 + wid * 8;
    const bf16* vsrc = V + (rowbase + 16 * (wid & 3) + (lane >> 2)) * DA + h * 64 + (wid >> 2) * 32 + (lane & 3) * 8;
    const int stoff = wid * 1024 + lane * 16;
    u32x4 kreg = *(const u32x4*)(ksrc + (size_t)kt_lo * 64 * DA), vreg = *(const u32x4*)(vsrc + (size_t)kt_lo * 64 * DA);
    *(LAS u32x4*)(shm + AT_K + stoff) = kreg; *(LAS u32x4*)(shm + AT_V + stoff) = vreg;
    __syncthreads();
    float mrun = -1e30f, lrun = 0.f; f32x16 o[2];
#pragma unroll
    for (int r = 0; r < 16; ++r) { o[0][r] = 0.f; o[1][r] = 0.f; }
    const int voff = ((lane >> 4) & 1) * 32 + (lane & 3) * 8 + (4 * hi + ((lane & 15) >> 2)) * 64;
    for (int kt = kt_lo; kt <= kt_hi; ++kt) {
        const int buf = (kt - kt_lo) & 1; const bool more = kt < kt_hi;
        if (more) { kreg = *(const u32x4*)(ksrc + (size_t)(kt + 1) * 64 * DA); vreg = *(const u32x4*)(vsrc + (size_t)(kt + 1) * 64 * DA); }
        const int dd = cq - kt;
        if (dd >= 0 && dd <= 8) {
            const LAS unsigned char* kb = shm + AT_K + buf * 8192 + hi * 1024 + r32 * 16;
            bf16x8 kf[8];
#pragma unroll
            for (int d0 = 0; d0 < 4; ++d0) { kf[2 * d0] = *(const LAS bf16x8*)(kb + d0 * 2048); kf[2 * d0 + 1] = *(const LAS bf16x8*)(kb + d0 * 2048 + 512); }
            const LAS float* tb = tbl + (575 - dd * 64 - (qi0 + r32) + 4 * hi);
            f32x16 p0, p1;
#pragma unroll
            for (int r = 0; r < 16; ++r) { p0[r] = tb[(r & 3) + 8 * (r >> 2)]; p1[r] = tb[32 + (r & 3) + 8 * (r >> 2)]; }
            const LAS unsigned char* vb = shm + AT_V + buf * 8192 + voff;
            s16x4 vlo[8], vhi[8];
#pragma unroll
            for (int i = 0; i < 8; ++i) { vlo[i] = vtr(vb + (i >> 2) * 4096 + (i & 3) * 1024); vhi[i] = vtr(vb + (i >> 2) * 4096 + (i & 3) * 1024 + 512); }
#pragma unroll
            for (int d0 = 0; d0 < 4; ++d0) {
                p0 = __builtin_amdgcn_mfma_f32_32x32x16_bf16(kf[2 * d0], qr[d0], p0, 0, 0, 0); p1 = __builtin_amdgcn_mfma_f32_32x32x16_bf16(kf[2 * d0 + 1], qr[d0], p1, 0, 0, 0); }
            float rm = __builtin_fmaxf(p0[0], p1[0]);
#pragma unroll
            for (int r = 1; r < 16; ++r) rm = __builtin_fmaxf(rm, __builtin_fmaxf(p0[r], p1[r]));
            { auto rr = __builtin_amdgcn_permlane32_swap(__float_as_uint(rm), __float_as_uint(rm), false, false); rm = __builtin_fmaxf(__uint_as_float(rr[0]), __uint_as_float(rr[1])); }
            const bool need = rm > mrun + 8.0f;
            if (__any(need)) {
                const float mnew = need ? rm : mrun; const float f = __builtin_amdgcn_exp2f(mrun - mnew); mrun = mnew; lrun *= f;
                if (hi == 0) wsf[r32] = f;
#pragma unroll
                for (int r = 0; r < 16; ++r) { const float fo = wsf[crow(r, hi)]; o[0][r] *= fo; o[1][r] *= fo; }
            }
            float ls = 0.f;
#pragma unroll
            for (int r = 0; r < 16; ++r) { p0[r] = __builtin_amdgcn_exp2f(p0[r] - mrun); p1[r] = __builtin_amdgcn_exp2f(p1[r] - mrun); ls += p0[r] + p1[r]; }
            lrun += ls;
            u32x4 pw0, pw1, pw2, pw3;
            pw0 = (u32x4){pk2(p0[0], p0[1]), pk2(p0[2], p0[3]), pk2(p0[4], p0[5]), pk2(p0[6], p0[7])};
            pw1 = (u32x4){pk2(p0[8], p0[9]), pk2(p0[10], p0[11]), pk2(p0[12], p0[13]), pk2(p0[14], p0[15])};
            pw2 = (u32x4){pk2(p1[0], p1[1]), pk2(p1[2], p1[3]), pk2(p1[4], p1[5]), pk2(p1[6], p1[7])};
            pw3 = (u32x4){pk2(p1[8], p1[9]), pk2(p1[10], p1[11]), pk2(p1[12], p1[13]), pk2(p1[14], p1[15])};
#define VFRAG(i) ((bf16x8){vlo[i][0], vlo[i][1], vlo[i][2], vlo[i][3], vhi[i][0], vhi[i][1], vhi[i][2], vhi[i][3]})
#pragma unroll
            for (int d0 = 0; d0 < 2; ++d0) {
                o[d0] = __builtin_amdgcn_mfma_f32_32x32x16_bf16(__builtin_bit_cast(bf16x8, pw0), VFRAG(d0 * 4 + 0), o[d0], 0, 0, 0);
                o[d0] = __builtin_amdgcn_mfma_f32_32x32x16_bf16(__builtin_bit_cast(bf16x8, pw1), VFRAG(d0 * 4 + 1), o[d0], 0, 0, 0);
                o[d0] = __builtin_amdgcn_mfma_f32_32x32x16_bf16(__builtin_bit_cast(bf16x8, pw2), VFRAG(d0 * 4 + 2), o[d0], 0, 0, 0);
                o[d0] = __builtin_amdgcn_mfma_f32_32x32x16_bf16(__builtin_bit_cast(bf16x8, pw3), VFRAG(d0 * 4 + 3), o[d0], 0, 0, 0);
            }
#undef VFRAG
        }
        if (more) { *(LAS u32x4*)(shm + AT_K + (buf ^ 1) * 8192 + stoff) = kreg; *(LAS u32x4*)(shm + AT_V + (buf ^ 1) * 8192 + stoff) = vreg; }
        __syncthreads();
    }
    { auto rr = __builtin_amdgcn_permlane32_swap(__float_as_uint(lrun), __float_as_uint(lrun), false, false); lrun = __uint_as_float(rr[0]) + __uint_as_float(rr[1]); }
    if (hi == 0) wsf[32 + r32] = lrun;
    LAS bf16* stg = (LAS bf16*)(shm + AT_OST) + wid * 2048;
#pragma unroll
    for (int r = 0; r < 16; ++r) { const int orow = crow(r, hi); const float rl = __builtin_amdgcn_rcpf(wsf[32 + orow]);
        stg[orow * 64 + r32] = (bf16)f2bf(o[0][r] * rl); stg[orow * 64 + 32 + r32] = (bf16)f2bf(o[1][r] * rl); }
    bf16* Ow = AC + qrow0 * D + h * 64;
#pragma unroll
    for (int i = 0; i < 4; ++i) { const int row = i * 8 + (lane >> 3), ch = lane & 7; const u32x4 v = *(const LAS u32x4*)(stg + row * 64 + ch * 8); *(u32x4*)(Ow + (size_t)row * D + ch * 8) = v; }
    __syncthreads();
}

constexpr int CV_IN = 0, CV_OUT = 62 * 1024;
typedef float f32x2 __attribute__((ext_vector_type(2)));
__device__ __forceinline__ void conv_unit(int unit, const bf16* G, const float* dwk, const float* dwb, const float* lng, const float* lnb, bf16* AC, LAS unsigned char* shm) {
    const int tid = threadIdx.x, lane = tid & 63; const int wid = __builtin_amdgcn_readfirstlane(tid >> 6);
    const int b = unit >> 6, c = unit & 63;
    const int cp = tid & 255, tg = tid >> 8;
    f32x2 w[31];
#pragma unroll
    for (int j = 0; j < 31; ++j) w[j] = *(const f32x2*)(dwk + j * DC + 2 * cp);
    const f32x2 bias = *(const f32x2*)(dwb + 2 * cp);
    LAS float* obuf = (LAS float*)(shm + CV_OUT);
    const f32x4 g0 = *(const f32x4*)(lng + lane * 8), g1 = *(const f32x4*)(lng + lane * 8 + 4), b0 = *(const f32x4*)(lnb + lane * 8), b1 = *(const f32x4*)(lnb + lane * 8 + 4);
    for (int half = 0; half < 2; ++half) {
        const int t0 = c * 64 + half * 32;
        { u32x4 v[8];
#pragma unroll
            for (int q = 0; q < 8; ++q) { const int idx = tid + q * (NWAVES * 64), ts = t0 - 30 + (idx >> 6); v[q] = (u32x4){0u, 0u, 0u, 0u};
                if (idx < 62 * 64 && ts >= 0) v[q] = *(const u32x4*)(G + ((size_t)b * SEQ + ts) * DC + (idx & 63) * 8); }
#pragma unroll
            for (int q = 0; q < 8; ++q) { const int idx = tid + q * (NWAVES * 64); if (idx < 62 * 64) *(LAS u32x4*)(shm + CV_IN + idx * 16) = v[q]; } }
        __syncthreads();
#pragma unroll 1
        for (int blk = 0; blk < 2; ++blk) {
            const int i0 = 16 * tg + 8 * blk;
            f32x2 acc[8];
#pragma unroll
            for (int i = 0; i < 8; ++i) acc[i] = bias;
            const LAS unsigned* ip = (const LAS unsigned*)(shm + CV_IN) + i0 * 256 + cp;
#pragma unroll
            for (int k = 0; k < 38; ++k) { const unsigned raw = ip[k * 256]; f32x2 xv; xv.x = __builtin_bit_cast(float, raw << 16); xv.y = __builtin_bit_cast(float, raw & 0xffff0000u);
#pragma unroll
                for (int i = 0; i < 8; ++i) { const int j = k - i; if (j >= 0 && j <= 30) acc[i] += w[j] * xv; } }
#pragma unroll
            for (int i = 0; i < 8; ++i) *(LAS f32x2*)(obuf + (i0 + i) * DC + 2 * cp) = acc[i];
        }
        __syncthreads();
#pragma unroll
        for (int q = 0; q < 4; ++q) { const int i = wid * 4 + q;
            const f32x4 v0 = *(const LAS f32x4*)(obuf + i * DC + lane * 8), v1 = *(const LAS f32x4*)(obuf + i * DC + lane * 8 + 4);
            const float mean = wave_sum((v0[0] + v0[1]) + (v0[2] + v0[3]) + (v1[0] + v1[1]) + (v1[2] + v1[3])) * (1.0f / DC);
            const f32x4 e0 = v0 - mean, e1 = v1 - mean;
            const float var = wave_sum((e0[0] * e0[0] + e0[1] * e0[1]) + (e0[2] * e0[2] + e0[3] * e0[3]) + (e1[0] * e1[0] + e1[1] * e1[1]) + (e1[2] * e1[2] + e1[3] * e1[3])) * (1.0f / DC);
            const float rstd = __builtin_amdgcn_rsqf(var + 1e-6f);
            f32x4 y0 = e0 * rstd * g0 + b0, y1 = e1 * rstd * g1 + b1;
#pragma unroll
            for (int e = 0; e < 4; ++e) { y0[e] = y0[e] * pg8::sigmoidf_fast(y0[e]); y1[e] = y1[e] * pg8::sigmoidf_fast(y1[e]); }
            u32x4 ov; ov.x = pk2(y0[0], y0[1]); ov.y = pk2(y0[2], y0[3]); ov.z = pk2(y1[0], y1[1]); ov.w = pk2(y1[2], y1[3]);
            *(u32x4*)(AC + ((size_t)b * SEQ + t0 + i) * D + DA + lane * 8) = ov; }
        __syncthreads();
    }
}

#define XB_TMO      128
#define XB_XCNT(j)  (256  + 64 * (j))
#define XB_XSUB(j)  (1280 + 64 * (j))
#define XB_XGEN(j)  (2304 + 64 * (j))
#define XB_TOP      3328
#define XB_TOPGEN   3392
#define XCD_BAR_WORDS 3456
#define XB_SPIN_CAP (1u << 18)
__device__ __forceinline__ unsigned xb_ld(unsigned* p)              { return __hip_atomic_load(p, __ATOMIC_RELAXED, __HIP_MEMORY_SCOPE_AGENT); }
__device__ __forceinline__ unsigned xb_add(unsigned* p, unsigned v) { return __hip_atomic_fetch_add(p, v, __ATOMIC_RELAXED, __HIP_MEMORY_SCOPE_AGENT); }
__device__ __forceinline__ unsigned xb_xcc_id() { return (unsigned)__builtin_amdgcn_s_getreg((3 << 11) | 20) & 0xFu; }
#define XB_SPIN(cond, bar) do { unsigned _sp = 0; while (cond) { __builtin_amdgcn_s_sleep(1); \
    if ((++_sp & 255u) == 0u) { if (xb_ld(&(bar)[XB_TMO])) break; if (_sp > XB_SPIN_CAP) { atomicAdd(&(bar)[XB_TMO], 1u); break; } } } } while (0)
struct XcdBarrier { unsigned* bar; unsigned x; volatile LAS unsigned* st; };
__device__ __forceinline__ XcdBarrier xcd_barrier_post(unsigned* bar, volatile LAS unsigned* st) {
    XcdBarrier b; b.bar = bar; b.x = xb_xcc_id(); b.st = st;
    if (threadIdx.x == 0) st[2] = xb_add(&bar[XB_XCNT(b.x)], 1u);
    return b;
}
__device__ __forceinline__ void xcd_barrier_complete(unsigned* bar, unsigned x, unsigned& nloc, unsigned& nx, unsigned& bal) {
    const unsigned G = gridDim.x * gridDim.y * gridDim.z;
    unsigned sum, cnt, mine, sp = 0u;
    for (;;) {
        sum = 0u; cnt = 0u; mine = 0u;
        bal = 1u;
#pragma unroll
        for (unsigned j = 0; j < 16; ++j) { const unsigned c = xb_ld(&bar[XB_XCNT(j)]); sum += c; cnt += (c > 0u) ? 1u : 0u; mine = (j == x) ? c : mine; if (c != ((j < 8u) ? 32u : 0u)) bal = 0u; }
        if (sum == G) break;
        __builtin_amdgcn_s_sleep(1);
        if ((++sp & 255u) == 0u) { if (xb_ld(&bar[XB_TMO])) break; if (sp > XB_SPIN_CAP) { atomicAdd(&bar[XB_TMO], 1u); break; } }
    }
    nloc = mine > 0u ? mine : 1u; nx = cnt > 0u ? cnt : 1u;
}
__device__ __forceinline__ void xcd_barrier(const XcdBarrier& b) {
    asm volatile("s_waitcnt vmcnt(0)" ::: "memory");
    __syncthreads();
    if (threadIdx.x == 0) {
        unsigned* bar = b.bar;
        __builtin_amdgcn_s_waitcnt(0);
        unsigned nloc = b.st[0], nx = b.st[1];
        if (nloc == 0u) { unsigned bal; xcd_barrier_complete(bar, b.x, nloc, nx, bal); b.st[0] = nloc; b.st[1] = nx; b.st[3] = bal; }
        const unsigned old = xb_add(&bar[XB_XSUB(b.x)], 1u);
        const unsigned gen = old / nloc;
        if (old + 1u == (gen + 1u) * nloc) {
            __builtin_amdgcn_fence(__ATOMIC_RELEASE, "agent");
            asm volatile("s_waitcnt vmcnt(0)" ::: "memory");
            const unsigned og = xb_add(&bar[XB_TOP], 1u);
            const unsigned tg = og / nx;
            if (og + 1u == (tg + 1u) * nx) xb_add(&bar[XB_TOPGEN], 1u);
            else XB_SPIN(xb_ld(&bar[XB_TOPGEN]) == tg, bar);
            __builtin_amdgcn_fence(__ATOMIC_ACQUIRE, "agent");
            asm volatile("s_waitcnt vmcnt(0)" ::: "memory");
        } else {
            XB_SPIN(xb_ld(&bar[XB_TOPGEN]) == gen, bar);
            __builtin_amdgcn_fence(__ATOMIC_ACQUIRE, "agent");
            asm volatile("s_waitcnt vmcnt(0)" ::: "memory");
        }
    }
    __syncthreads();
}
__device__ __forceinline__ void xcd_local_barrier(const XcdBarrier& b, unsigned* lw) {
    asm volatile("s_waitcnt vmcnt(0)" ::: "memory");
    __syncthreads();
    if (threadIdx.x == 0) {
        __builtin_amdgcn_s_waitcnt(0);
        unsigned* w = lw + 64 * b.x;
        const unsigned old = xb_add(w, 1u);
        const unsigned target = (old / 32u + 1u) * 32u;
        XB_SPIN(xb_ld(w) < target, b.bar);
        __builtin_amdgcn_fence(__ATOMIC_ACQUIRE, "agent");
        asm volatile("s_waitcnt vmcnt(0)" ::: "memory");
    }
    __syncthreads();
}
__device__ __forceinline__ void xcd_pair_barrier(const XcdBarrier& b, unsigned* lw) {
    asm volatile("s_waitcnt vmcnt(0)" ::: "memory");
    __syncthreads();
    if (threadIdx.x == 0) {
        __builtin_amdgcn_s_waitcnt(0);
        const unsigned old = xb_add(lw + 64 * b.x, 1u);
        if (old == 31u) { if (!(b.x & 1u)) { __builtin_amdgcn_fence(__ATOMIC_RELEASE, "agent"); asm volatile("s_waitcnt vmcnt(0)" ::: "memory"); }
                          xb_add(lw + 64 * (8 + b.x), 1u); }
        XB_SPIN(xb_ld(lw + 64 * (8 + b.x)) == 0u, b.bar);
        if (b.x & 1u) XB_SPIN(xb_ld(lw + 64 * (8 + b.x - 1u)) == 0u, b.bar);
        __builtin_amdgcn_fence(__ATOMIC_ACQUIRE, "agent");
        asm volatile("s_waitcnt vmcnt(0)" ::: "memory");
    }
    __syncthreads();
}
constexpr size_t WS_LBAR = 98304;
constexpr size_t WS_BAR = 65536;
constexpr size_t CTL_ZERO_BYTES = 131072;
constexpr int LDS_MISC = 131072 + 64;
constexpr int LDS_RTAB = 131072 + 1024;

struct Args { const float* in[18]; float* out; unsigned char* ws; int lo, hi, li, pad; };

__global__ void __launch_bounds__(NWAVES * 64, 2) fwd_kernel(Args a) {
    extern __shared__ __attribute__((aligned(16))) unsigned char lds_raw[];
    LAS unsigned char* lds = (LAS unsigned char*)lds_raw;
    cg::grid_group grid = cg::this_grid();
    const int tid = threadIdx.x, lane = tid & 63, wave = __builtin_amdgcn_readfirstlane(tid >> 6);
    const int G = gridDim.x, bx = blockIdx.x;
    const int vcu = (G % 8 == 0) ? (bx % 8) * (G / 8) + bx / 8 : bx;
    Ptrs P;
    P.x = a.in[0]; P.n1 = a.in[1]; P.g1 = a.in[2]; P.u1 = a.in[3]; P.d1 = a.in[4]; P.nm = a.in[5]; P.win = a.in[6]; P.relb = a.in[7]; P.dwk = a.in[8]; P.dwb = a.in[9];
    P.lng = a.in[10]; P.lnb = a.in[11]; P.wout = a.in[12]; P.n2 = a.in[13]; P.g2 = a.in[14]; P.u2 = a.in[15]; P.d2 = a.in[16]; P.nf = a.in[17]; P.out = a.out; P.ws = a.ws;
    unsigned char* ws = a.ws;
    bf16* XB = (bf16*)(ws + WS_XB); bf16* HB = (bf16*)(ws + WS_H);
    unsigned char* ob = (unsigned char*)P.out;
    bf16* QB = (bf16*)ob; bf16* KB = (bf16*)(ob + QKVG_STRIDE); bf16* VB = (bf16*)(ob + 2 * QKVG_STRIDE); bf16* GB = (bf16*)(ob + 3 * QKVG_STRIDE); bf16* AC = (bf16*)(ws + WS_AC);
    float* ssq0 = (float*)(ws + WS_SSQ0); float* ssq1 = (float*)(ws + WS_SSQ1); float* ssq2 = (float*)(ws + WS_SSQ2); float* ssq3 = (float*)(ws + WS_SSQ3);
    const int lo = a.lo, hi = a.hi;
#define IN(k) (lo <= (k) && (k) < hi)
#define SEAM(k) do { if (IN(k) && IN((k) + 1)) xcd_barrier(bar); } while (0)
    if (tid < 4) ((LAS unsigned*)(lds + LDS_MISC))[tid] = 0u;
    __syncthreads();
    XcdBarrier bar = xcd_barrier_post((unsigned*)(ws + WS_BAR) + a.li * XCD_BAR_WORDS, (volatile LAS unsigned*)(lds + LDS_MISC));
    if (hi < 0) grid.sync();

    const bool defer = (G == 256) && lo == 0 && hi == 10;
    if (IN(0)) { p0_prologue(P, lds, vcu * NWAVES + wave, G * NWAVES, wave, lane, !defer); }
    SEAM(0);
    const volatile LAS unsigned* mst = (const volatile LAS unsigned*)(lds + LDS_MISC);
    const bool loc = defer && (mst[3] == 1u) && (bar.x < 8u);
    const int cb = loc ? (int)(mst[2] * 8u + bar.x) : bx;
    unsigned* lbw = (unsigned*)(ws + WS_LBAR);
#define LSEAM(k) do { if (IN(k) && IN((k) + 1)) { if (loc) xcd_local_barrier(bar, lbw); else xcd_barrier(bar); } } while (0)
    if (IN(1)) {
        pg8::Gemm g{XB, (const bf16*)(ws + WS_WGU1), M, 2 * FF, D}; pg8::StaticOrder S; S.init(M, 2 * FF, G, cb);
        pg8::EpiProj<0> E{nullptr, 512, 0, 1.f, 0, HB, FF, ssq0, (LAS float*)(lds + LDS_RTAB)};
        pg8::gemm_phase<pg8::EpiProj<0>, pg8::StaticOrder, true, true>(lds, g, S, E);
        if (defer && cb >= 128) { convert_weights(P, lds, 1, (cb - 128) * NWAVES + wave, 128 * NWAVES, wave, lane, loc);
            if (loc) {
                asm volatile("s_waitcnt vmcnt(0)" ::: "memory"); __syncthreads();
                if (tid == 0) __hip_atomic_fetch_add(lbw + 64 * 8, 1u, __ATOMIC_RELAXED, __HIP_MEMORY_SCOPE_AGENT);
            } }
    }
    if (loc) {
        if (IN(1) && IN(2)) { if (tid == 0) { XB_SPIN(xb_ld(lbw + 64 * 8) < 128u, bar.bar); } xcd_local_barrier(bar, lbw); }
    } else SEAM(1);
    if (IN(2)) {
        pg8::Gemm g{HB, (const bf16*)(ws + WS_WD1), M, D, FF}; pg8::StaticOrder S; S.init(M, D, G, cb);
        pg8::EpiResidW<false> E{P.x, XB, ssq1, 0.5f};
        pg8::gemm_phase<pg8::EpiResidW<false>, pg8::StaticOrder, true, true>(lds, g, S, E);
    }
    LSEAM(2);
    if (IN(3)) {
        pg8::Gemm g{XB, (const bf16*)(ws + WS_WIN), M, DIN, D}; pg8::StaticOrder S; S.init(M, DIN, G, cb);
        pg8::EpiProj<1> E{QB, DA, (size_t)QKVG_STRIDE / 2, QSCALE, 6, GB, DC, ssq1, (LAS float*)(lds + LDS_RTAB)};
        pg8::gemm_phase<pg8::EpiProj<1>, pg8::StaticOrder, true, true>(lds, g, S, E);
        if (defer && cb >= 128) { convert_weights(P, lds, 2, (cb - 128) * NWAVES + wave, 128 * NWAVES, wave, lane, loc);
            if (loc) { asm volatile("s_waitcnt vmcnt(0)" ::: "memory"); __syncthreads(); if (tid == 0) __hip_atomic_fetch_add(lbw + 64 * 9, 1u, __ATOMIC_RELAXED, __HIP_MEMORY_SCOPE_AGENT); } }
    }
    if (loc) {
        if (IN(3) && IN(4)) xcd_pair_barrier(bar, lbw + 64 * 16);
    } else SEAM(3);
    if (IN(4)) {
        if (loc) {
            const int xcd = cb & 7, j = cb >> 3;
            for (int i = 0; i < 2; ++i) { const int idx = j * 2 + i; attn_unit(xcd >> 1, idx & 7, 8 * (xcd & 1) + (idx >> 3), QB, KB, VB, AC, P.relb, lds); }
        } else if (G == 256) {
            const int xcd = cb & 7, j = cb >> 3;
            for (int i = 0; i < 2; ++i) { const int idx = j * 2 + i, bh = xcd * 4 + (idx >> 4), grp = idx & 15; attn_unit(bh >> 3, bh & 7, grp, QB, KB, VB, AC, P.relb, lds); }
        } else {
            for (int u = cb; u < 512; u += G) { const int bh = u >> 4, grp = u & 15; attn_unit(bh >> 3, bh & 7, grp, QB, KB, VB, AC, P.relb, lds); }
        }
    }
    if (IN(5)) {
        if (loc) conv_unit(32 * (cb & 7) + (cb >> 3), GB, P.dwk, P.dwb, P.lng, P.lnb, AC, lds);
        else for (int u = cb; u < M / 64; u += G) conv_unit(u, GB, P.dwk, P.dwb, P.lng, P.lnb, AC, lds);
    }
    if (loc && IN(5) && IN(6) && tid == 0) { XB_SPIN(xb_ld(lbw + 64 * 9) < 128u, bar.bar); }
    LSEAM(5);
    if (loc && IN(5) && IN(6) && tid == 0) xb_add(lbw + 64 * 10, 1u);
    if (IN(6)) {
        pg8::Gemm g{AC, (const bf16*)(ws + WS_WOUT), M, D, D}; pg8::StaticOrder S; S.init(M, D, G, cb);
        pg8::EpiResidW<true> E{XB, XB, ssq2, 1.0f};
        pg8::gemm_phase<pg8::EpiResidW<true>, pg8::StaticOrder, true, true>(lds, g, S, E);
    }
    LSEAM(6);
    if (IN(7)) {
        pg8::Gemm g{XB, (const bf16*)(ws + WS_WGU2), M, 2 * FF, D}; pg8::StaticOrder S; S.init(M, 2 * FF, G, cb);
        pg8::EpiProj<0> E{nullptr, 512, 0, 1.f, 0, HB, FF, ssq2, (LAS float*)(lds + LDS_RTAB)};
        pg8::gemm_phase<pg8::EpiProj<0>, pg8::StaticOrder, true, true>(lds, g, S, E);
    }
    if (loc && IN(7) && IN(8) && tid == 0) { XB_SPIN(xb_ld(lbw + 64 * 10) < (unsigned)G, bar.bar); }
    LSEAM(7);
    if (IN(8)) {
        pg8::Gemm g{HB, (const bf16*)(ws + WS_WD2), M, D, FF}; pg8::StaticOrder S; S.init(M, D, G, cb);
        if (G == 256) {
            pg8::EpiFinal E{XB, P.out, ssq3, (unsigned*)ws, P.nf, 0.5f, (LAS float*)(lds + LDS_RTAB)};
            pg8::gemm_phase<pg8::EpiFinal, pg8::StaticOrder, true, true>(lds, g, S, E);
        } else {
            pg8::EpiResid<true, true> E{XB, P.out, nullptr, ssq3, 0.5f};
            pg8::gemm_phase<pg8::EpiResid<true, true>, pg8::StaticOrder, true, true>(lds, g, S, E);
        }
    }
    if (G != 256) SEAM(8);
    if (IN(9) && G != 256) {
        const int gw = vcu * NWAVES + wave, NGW = G * NWAVES;
        f32x4 gv[4];
#pragma unroll
        for (int j = 0; j < 4; ++j) gv[j] = ((const f32x4*)P.nf)[lane + 64 * j];
        for (int m = gw; m < M; m += 2 * NGW) {
            const int m1 = (m + NGW < M) ? m + NGW : m;
            const float rs0 = pg8::row_rstd(ssq3, m), rs1 = pg8::row_rstd(ssq3, m1);
            f32x4* xr0 = (f32x4*)(P.out + (size_t)m * D) + lane; f32x4* xr1 = (f32x4*)(P.out + (size_t)m1 * D) + lane;
            f32x4 v0[4], v1[4];
#pragma unroll
            for (int j = 0; j < 4; ++j) { v0[j] = xr0[64 * j]; v1[j] = xr1[64 * j]; }
#pragma unroll
            for (int j = 0; j < 4; ++j) { xr0[64 * j] = v0[j] * rs0 * gv[j]; if (m1 != m) xr1[64 * j] = v1[j] * rs1 * gv[j]; }
        }
    }
#undef IN
#undef SEAM
}

#ifndef N_LAUNCH_SPLIT
#define N_LAUNCH_SPLIT 0
#endif

extern "C" void kernel_launch(void* const* d_in, const int* in_sizes, int n_in, void* d_out, int out_size, void* d_ws, size_t ws_size, hipStream_t stream) {
    static int grid = 0;
    if (grid == 0) {
        int dev = 0, cus = 0, per_cu = 0;
        if (n_in != 18 || out_size != M * D || ws_size < WS_END) { fprintf(stderr, "kernel_launch: unexpected shapes (n_in %d out %d ws %zu)\n", n_in, out_size, ws_size); grid = -1; return; }
        hipGetDevice(&dev); hipDeviceGetAttribute(&cus, hipDeviceAttributeMultiprocessorCount, dev);
        if (hipFuncSetAttribute((const void*)fwd_kernel, hipFuncAttributeMaxDynamicSharedMemorySize, LDS_BYTES) != hipSuccess) { fprintf(stderr, "kernel_launch: hipFuncSetAttribute failed\n"); grid = -1; return; }
        if (hipOccupancyMaxActiveBlocksPerMultiprocessor(&per_cu, (const void*)fwd_kernel, NWAVES * 64, LDS_BYTES) != hipSuccess || per_cu < 1) { fprintf(stderr, "kernel_launch: occupancy query says %d\n", per_cu); per_cu = 1; }
        (void)hipGetLastError();
        grid = cus * per_cu;
    }
    if (grid < 0) return;
    if (hipMemsetAsync(d_ws, 0, CTL_ZERO_BYTES, stream) != hipSuccess) { fprintf(stderr, "kernel_launch: memset of the control words failed\n"); return; }
    Args a{};
    for (int i = 0; i < 18; ++i) a.in[i] = (const float*)d_in[i];
    a.out = (float*)d_out; a.ws = (unsigned char*)d_ws;
#if N_LAUNCH_SPLIT
    for (int p = 0; p < 10; ++p) { a.lo = p; a.hi = p + 1; hipLaunchKernelGGL(fwd_kernel, dim3(grid), dim3(NWAVES * 64), LDS_BYTES, stream, a); }
#else
    a.lo = 0; a.hi = 10;
    void* args[] = {&a};
    hipError_t e = hipLaunchCooperativeKernel((const void*)fwd_kernel, dim3(grid), dim3(NWAVES * 64), args, LDS_BYTES, stream);
    if (e != hipSuccess) fprintf(stderr, "cooperative launch failed: %s (grid %d)\n", hipGetErrorString(e), grid);
#endif
}
```

```cpp
#include <hip/hip_runtime.h>
#include <hip/hip_cooperative_groups.h>
#include <cstdio>
#include <cstdint>
namespace cg = cooperative_groups;

namespace pg8 {
#define PG8_LAS __attribute__((address_space(3)))
typedef unsigned short bf16_t;
typedef short bf16x8 __attribute__((ext_vector_type(8)));
typedef float f32x4 __attribute__((ext_vector_type(4)));
typedef unsigned u32x4 __attribute__((ext_vector_type(4)));
typedef unsigned u32x2 __attribute__((ext_vector_type(2)));
constexpr int BM = 256, BK = 64, HALF = 128, HTB = HALF * BK * 2, STAGE_BYTES = 8 * HTB, NXCD = 8, WGM = 8;

__host__ __device__ __forceinline__ int lds_byte(int r, int c) { const int st = (r >> 4) * 2 + (c >> 5), rr = r & 15, cc = c & 31, ob = rr * 64 + cc * 2; return st * 1024 + (ob ^ (((ob >> 9) & 1) << 5)); }
__host__ __device__ __forceinline__ void stage_rc(int b, int& R, int& C) { const int st = b / 1024, sb = b % 1024, swz = sb ^ (((sb >> 9) & 1) << 5); R = (st >> 1) * 16 + swz / 64; C = (st & 1) * 32 + (swz % 64) / 2; }
__host__ __device__ __forceinline__ int perm32(int rho) { const int n = rho >> 4, i = rho & 15; return 8 * (i >> 2) + 4 * n + (i & 3); }

struct Unit { int pm, pn; };
struct Gemm { const bf16_t* A; const bf16_t* Bt; int M, N, K; };

struct StaticOrder {
    int nM, nN, nwg, G, c;
    __host__ __device__ void init(int M, int N, int G_, int c_) { nM = M / BM; nN = N / BM; nwg = nM * nN; G = G_; c = c_; }
    __host__ __device__ bool next(int i, Unit& u) const {
        const long L = (long)i * G + c; if (L >= nwg) return false;
        int wgid = (int)L; { const int q = nwg / NXCD, r = nwg % NXCD, xcd = wgid % NXCD, off = wgid / NXCD; wgid = (xcd < r ? xcd * (q + 1) : r * (q + 1) + (xcd - r) * q) + off; }
        const int nig = WGM * nN, gid = wgid / nig, fm = gid * WGM, gsz = (nM - fm) < WGM ? (nM - fm) : WGM;
        u.pm = fm + ((wgid % nig) % gsz); u.pn = (wgid % nig) / gsz; return true;
    }
    __device__ __forceinline__ void a_ready(const Unit&) const {}
    __device__ __forceinline__ void done(const Unit&) const {}
};

typedef float f32x2 __attribute__((ext_vector_type(2)));
typedef __bf16 bf16x2_t __attribute__((ext_vector_type(2)));
__device__ __forceinline__ unsigned cvt_pk_bf16(float lo, float hi) { f32x2 v = {lo, hi}; bf16x2_t b = __builtin_convertvector(v, bf16x2_t); return __builtin_bit_cast(unsigned, b); }
__device__ __forceinline__ float sigmoidf_fast(float v) { return __builtin_amdgcn_rcpf(1.0f + __builtin_amdgcn_exp2f(-1.4426950408889634f * v)); }

__device__ __forceinline__ float row_rstd(const float* ssq, int r) {
    const f32x4* p = (const f32x4*)(ssq + (size_t)r * 16);
    const f32x4 a = p[0], b = p[1], c = p[2], d = p[3];
    const float s = ((a[0] + a[1]) + (a[2] + a[3])) + ((b[0] + b[1]) + (b[2] + b[3])) + ((c[0] + c[1]) + (c[2] + c[3])) + ((d[0] + d[1]) + (d[2] + d[3]));
    return __builtin_amdgcn_rsqf(s * (1.0f / 1024.0f) + 1e-6f);
}

template <int KIND> struct EpiProj {
    static constexpr bool PERM = true, AFTER_DRAIN = false;
    bf16_t* Oplain; int split_cols; size_t split_stride; float scale0; int n_plain;
    bf16_t* Ogated; int ldg; const float* ssq; PG8_LAS float* rtab;
    static constexpr bool WANTS_NEXT = true;
    __device__ __forceinline__ void prefill(const Unit& u) const {
        const int t = threadIdx.x, rr = t >> 1, hf = t & 1; const f32x4* p = (const f32x4*)(ssq + (size_t)(u.pm * BM + rr) * 16 + hf * 8); const f32x4 a = p[0], b = p[1];
        float sm = ((a[0] + a[1]) + (a[2] + a[3])) + ((b[0] + b[1]) + (b[2] + b[3])); sm += __shfl_xor(sm, 1);
        if (hf == 0) rtab[rr] = __builtin_amdgcn_rsqf(sm * (1.0f / 1024.0f) + 1e-6f);
        asm volatile("s_waitcnt lgkmcnt(0)" ::: "memory"); __builtin_amdgcn_s_barrier(); asm volatile("" ::: "memory");
    }
    __device__ __forceinline__ void operator()(const f32x4 (&acc)[2][2][4][2], const Unit& u, int wr, int wc, int fr, int fq, bool has_next, const Unit& nxt, int ui) const {
        const int row0 = u.pm * BM + wr * 64 + fr;
        f32x4 na = {0.f, 0.f, 0.f, 0.f}, nb = {0.f, 0.f, 0.f, 0.f};
        const int trr = threadIdx.x >> 1, thf = threadIdx.x & 1;
        if (has_next) { const f32x4* p = (const f32x4*)(ssq + (size_t)(nxt.pm * BM + trr) * 16 + thf * 8); na = p[0]; nb = p[1]; }
        const PG8_LAS float* rloc = rtab + (ui & 1) * 256 + wr * 64 + fr;
        if (u.pn < n_plain) {
            int colt = u.pn * BM; const int t = colt / split_cols; bf16_t* base = Oplain + (size_t)t * split_stride; colt -= t * split_cols;
            const float sc = (t == 0) ? scale0 : 1.f; const int col0 = colt + wc * 32 + 8 * fq;
#pragma unroll
            for (int ai = 0; ai < 2; ++ai)
#pragma unroll
                for (int m = 0; m < 4; ++m) { const int r = row0 + ai * HALF + m * 16; const float rs = rloc[ai * HALF + m * 16] * sc; bf16_t* rowp = base + (size_t)r * split_cols + col0;
#pragma unroll
                    for (int bj = 0; bj < 2; ++bj) { const f32x4 v0 = acc[ai][bj][m][0] * rs, v1 = acc[ai][bj][m][1] * rs;
                        u32x4 w; w.x = cvt_pk_bf16(v0[0], v0[1]); w.y = cvt_pk_bf16(v0[2], v0[3]); w.z = cvt_pk_bf16(v1[0], v1[1]); w.w = cvt_pk_bf16(v1[2], v1[3]);
                        *(u32x4*)(rowp + bj * HALF) = w; } }
        } else {
            const int col0 = (u.pn - n_plain) * HALF + wc * 32 + 8 * fq;
#pragma unroll
            for (int ai = 0; ai < 2; ++ai)
#pragma unroll
                for (int m = 0; m < 4; ++m) { const int r = row0 + ai * HALF + m * 16; const float rs = rloc[ai * HALF + m * 16];
                    float o[8];
                    const float kx = -1.4426950408889634f * rs, rs2 = rs * rs;
#pragma unroll
                    for (int n = 0; n < 2; ++n)
#pragma unroll
                        for (int e = 0; e < 4; ++e) { const float a = acc[ai][0][m][n][e], b = acc[ai][1][m][n][e];
                            if (KIND == 0) { const float sg = __builtin_amdgcn_rcpf(1.0f + __builtin_amdgcn_exp2f(a * kx)); o[n * 4 + e] = (a * b) * rs2 * sg; }
                            else { const float sg = __builtin_amdgcn_rcpf(1.0f + __builtin_amdgcn_exp2f(b * kx)); o[n * 4 + e] = (a * rs) * sg; } }
                    u32x4 w; w.x = cvt_pk_bf16(o[0], o[1]); w.y = cvt_pk_bf16(o[2], o[3]); w.z = cvt_pk_bf16(o[4], o[5]); w.w = cvt_pk_bf16(o[6], o[7]);
                    *(u32x4*)(Ogated + (size_t)r * ldg + col0) = w; }
        }
        if (has_next) { float sm = ((na[0] + na[1]) + (na[2] + na[3])) + ((nb[0] + nb[1]) + (nb[2] + nb[3])); sm += __shfl_xor(sm, 1);
            if (thf == 0) rtab[((ui + 1) & 1) * 256 + trr] = __builtin_amdgcn_rsqf(sm * (1.0f / 1024.0f) + 1e-6f); }
    }
};

__device__ __forceinline__ f32x4 bf4_to_f32(u32x2 w) { f32x4 r; r[0] = __builtin_bit_cast(float, w.x << 16); r[1] = __builtin_bit_cast(float, w.x & 0xffff0000u); r[2] = __builtin_bit_cast(float, w.y << 16); r[3] = __builtin_bit_cast(float, w.y & 0xffff0000u); return r; }
template <bool BASE_BF16, bool OUT_F32> struct EpiResid {
    static constexpr bool PERM = false, AFTER_DRAIN = false, WANTS_NEXT = false;
    const void* base; float* outf; bf16_t* outb; float* ssq_out; float alpha;
    __device__ __forceinline__ void operator()(const f32x4 (&acc)[2][2][4][2], const Unit& u, int wr, int wc, int fr, int fq) const {
        const int col0 = u.pn * BM + wc * 32 + 4 * fq; const int row0 = u.pm * BM + wr * 64 + fr;
        u32x2 bb[2][4][2][2];
        if constexpr (BASE_BF16) {
#pragma unroll
            for (int ai = 0; ai < 2; ++ai)
#pragma unroll
                for (int m = 0; m < 4; ++m)
#pragma unroll
                    for (int bj = 0; bj < 2; ++bj)
#pragma unroll
                        for (int n = 0; n < 2; ++n) bb[ai][m][bj][n] = *(const u32x2*)((const bf16_t*)base + (size_t)(row0 + ai * HALF + m * 16) * 1024 + col0 + bj * HALF + n * 16);
        }
#pragma unroll
        for (int ai = 0; ai < 2; ++ai) {
            f32x4 bf[4][2][2];
            if constexpr (!BASE_BF16) {
#pragma unroll
                for (int m = 0; m < 4; ++m)
#pragma unroll
                    for (int bj = 0; bj < 2; ++bj)
#pragma unroll
                        for (int n = 0; n < 2; ++n) bf[m][bj][n] = *(const f32x4*)((const float*)base + (size_t)(row0 + ai * HALF + m * 16) * 1024 + col0 + bj * HALF + n * 16);
            }
#pragma unroll
            for (int m = 0; m < 4; ++m) { const int r = row0 + ai * HALF + m * 16; const size_t off = (size_t)r * 1024 + col0; float s = 0.f;
#pragma unroll
                for (int bj = 0; bj < 2; ++bj)
#pragma unroll
                    for (int n = 0; n < 2; ++n) { f32x4 bs; if constexpr (BASE_BF16) bs = bf4_to_f32(bb[ai][m][bj][n]); else bs = bf[m][bj][n];
                        const f32x4 o = bs + acc[ai][bj][m][n] * alpha;
                        s += (o[0] * o[0] + o[1] * o[1]) + (o[2] * o[2] + o[3] * o[3]);
                        if constexpr (OUT_F32) *(f32x4*)(outf + off + bj * HALF + n * 16) = o;
                        else { u32x2 w; w.x = cvt_pk_bf16(o[0], o[1]); w.y = cvt_pk_bf16(o[2], o[3]); *(u32x2*)(outb + off + bj * HALF + n * 16) = w; } }
                s += __shfl_xor(s, 16); s += __shfl_xor(s, 32);
                if (fq == 0) ssq_out[(size_t)r * 16 + u.pn * 4 + wc] = s; }
        }
    }
};

template <bool BASE_BF16> struct EpiResidW {
    static constexpr bool PERM = true, AFTER_DRAIN = false, WANTS_NEXT = false;
    const void* base; bf16_t* outb; float* ssq_out; float alpha;
    __device__ __forceinline__ void operator()(const f32x4 (&acc)[2][2][4][2], const Unit& u, int wr, int wc, int fr, int fq) const {
        const int col0 = u.pn * BM + wc * 32 + 8 * fq; const int row0 = u.pm * BM + wr * 64 + fr;
        if constexpr (BASE_BF16) {
            u32x4 bb[2][4][2];
#pragma unroll
            for (int ai = 0; ai < 2; ++ai)
#pragma unroll
                for (int m = 0; m < 4; ++m)
#pragma unroll
                    for (int bj = 0; bj < 2; ++bj) bb[ai][m][bj] = *(const u32x4*)((const bf16_t*)base + (size_t)(row0 + ai * HALF + m * 16) * 1024 + col0 + bj * HALF);
#pragma unroll
            for (int ai = 0; ai < 2; ++ai)
#pragma unroll
                for (int m = 0; m < 4; ++m) { const int r = row0 + ai * HALF + m * 16; const size_t off = (size_t)r * 1024 + col0; float s = 0.f;
#pragma unroll
                    for (int bj = 0; bj < 2; ++bj) {
                        const f32x4 b0 = bf4_to_f32((u32x2){bb[ai][m][bj].x, bb[ai][m][bj].y}), b1 = bf4_to_f32((u32x2){bb[ai][m][bj].z, bb[ai][m][bj].w});
                        const f32x4 o0 = b0 + acc[ai][bj][m][0] * alpha, o1 = b1 + acc[ai][bj][m][1] * alpha;
                        s += ((o0[0] * o0[0] + o0[1] * o0[1]) + (o0[2] * o0[2] + o0[3] * o0[3])) + ((o1[0] * o1[0] + o1[1] * o1[1]) + (o1[2] * o1[2] + o1[3] * o1[3]));
                        u32x4 w; w.x = cvt_pk_bf16(o0[0], o0[1]); w.y = cvt_pk_bf16(o0[2], o0[3]); w.z = cvt_pk_bf16(o1[0], o1[1]); w.w = cvt_pk_bf16(o1[2], o1[3]);
                        *(u32x4*)(outb + off + bj * HALF) = w; }
                    s += __shfl_xor(s, 16); s += __shfl_xor(s, 32);
                    if (fq == 0) ssq_out[(size_t)r * 16 + u.pn * 4 + wc] = s; }
        } else {
            f32x4 cur[2][2][2], nx[2][2][2];
#define PG8_LDQ(dst, q) do { _Pragma("unroll") for (int mm = 0; mm < 2; ++mm) _Pragma("unroll") for (int bj = 0; bj < 2; ++bj) _Pragma("unroll") for (int n = 0; n < 2; ++n) \
                dst[mm][bj][n] = *(const f32x4*)((const float*)base + (size_t)(row0 + ((q) >> 1) * HALF + (((q) & 1) * 2 + mm) * 16) * 1024 + col0 + bj * HALF + n * 4); } while (0)
            PG8_LDQ(cur, 0);
#pragma unroll
            for (int q = 0; q < 4; ++q) {
                if (q < 3) PG8_LDQ(nx, q + 1);
                const int ai = q >> 1;
#pragma unroll
                for (int mm = 0; mm < 2; ++mm) { const int m = (q & 1) * 2 + mm; const int r = row0 + ai * HALF + m * 16; const size_t off = (size_t)r * 1024 + col0; float s = 0.f;
#pragma unroll
                    for (int bj = 0; bj < 2; ++bj) {
                        const f32x4 o0 = cur[mm][bj][0] + acc[ai][bj][m][0] * alpha, o1 = cur[mm][bj][1] + acc[ai][bj][m][1] * alpha;
                        s += ((o0[0] * o0[0] + o0[1] * o0[1]) + (o0[2] * o0[2] + o0[3] * o0[3])) + ((o1[0] * o1[0] + o1[1] * o1[1]) + (o1[2] * o1[2] + o1[3] * o1[3]));
                        u32x4 w; w.x = cvt_pk_bf16(o0[0], o0[1]); w.y = cvt_pk_bf16(o0[2], o0[3]); w.z = cvt_pk_bf16(o1[0], o1[1]); w.w = cvt_pk_bf16(o1[2], o1[3]);
                        *(u32x4*)(outb + off + bj * HALF) = w; }
                    s += __shfl_xor(s, 16); s += __shfl_xor(s, 32);
                    if (fq == 0) ssq_out[(size_t)r * 16 + u.pn * 4 + wc] = s; }
#pragma unroll
                for (int mm = 0; mm < 2; ++mm)
#pragma unroll
                    for (int bj = 0; bj < 2; ++bj)
#pragma unroll
                        for (int n = 0; n < 2; ++n) cur[mm][bj][n] = nx[mm][bj][n];
            }
#undef PG8_LDQ
        }
    }
};

struct EpiFinal {
    static constexpr bool PERM = true, AFTER_DRAIN = false, WANTS_NEXT = false;
    const bf16_t* base; float* out; float* ssq; unsigned* cnt; const float* gain; float alpha; PG8_LAS float* rtab;
    __device__ __forceinline__ void operator()(f32x4 (&acc)[2][2][4][2], const Unit& u, int wr, int wc, int fr, int fq) const {
        const int col0 = u.pn * BM + wc * 32 + 8 * fq; const int row0 = u.pm * BM + wr * 64 + fr;
        u32x4 bb[2][4][2];
#pragma unroll
        for (int ai = 0; ai < 2; ++ai)
#pragma unroll
            for (int m = 0; m < 4; ++m)
#pragma unroll
                for (int bj = 0; bj < 2; ++bj) bb[ai][m][bj] = *(const u32x4*)(base + (size_t)(row0 + ai * HALF + m * 16) * 1024 + col0 + bj * HALF);
#pragma unroll
        for (int ai = 0; ai < 2; ++ai)
#pragma unroll
            for (int m = 0; m < 4; ++m) { const int r = row0 + ai * HALF + m * 16; float s = 0.f;
#pragma unroll
                for (int bj = 0; bj < 2; ++bj)
#pragma unroll
                    for (int n = 0; n < 2; ++n) { const f32x4 o = bf4_to_f32(n ? (u32x2){bb[ai][m][bj].z, bb[ai][m][bj].w} : (u32x2){bb[ai][m][bj].x, bb[ai][m][bj].y}) + acc[ai][bj][m][n] * alpha; acc[ai][bj][m][n] = o;
                        s += (o[0] * o[0] + o[1] * o[1]) + (o[2] * o[2] + o[3] * o[3]); }
                s += __shfl_xor(s, 16); s += __shfl_xor(s, 32);
                if (fq == 0) __hip_atomic_store(ssq + (size_t)r * 16 + u.pn * 4 + wc, s, __ATOMIC_RELAXED, __HIP_MEMORY_SCOPE_AGENT); }
        asm volatile("s_waitcnt vmcnt(0)" ::: "memory");
        unsigned* c = cnt + 64 * u.pm;
        if ((threadIdx.x & 63) == 0) __hip_atomic_fetch_add(c, 1u, __ATOMIC_RELAXED, __HIP_MEMORY_SCOPE_AGENT);
        if (__builtin_amdgcn_readfirstlane(threadIdx.x >> 6) == 0) {
            unsigned spins = 0;
            while ((unsigned)__builtin_amdgcn_readfirstlane(__hip_atomic_load(c, __ATOMIC_RELAXED, __HIP_MEMORY_SCOPE_AGENT)) < 32u) { __builtin_amdgcn_s_sleep(2); if (++spins > (1u << 22)) break; }
            __builtin_amdgcn_fence(__ATOMIC_ACQUIRE, "agent"); asm volatile("s_waitcnt vmcnt(0)" ::: "memory");
        }
        __builtin_amdgcn_s_barrier(); asm volatile("" ::: "memory");
        { const int t = threadIdx.x, rr = t >> 1, hf = t & 1; const f32x4* p = (const f32x4*)(ssq + (size_t)(u.pm * BM + rr) * 16 + hf * 8); const f32x4 a = p[0], b = p[1];
          float sm = ((a[0] + a[1]) + (a[2] + a[3])) + ((b[0] + b[1]) + (b[2] + b[3])); sm += __shfl_xor(sm, 1);
          if (hf == 0) rtab[rr] = __builtin_amdgcn_rsqf(sm * (1.0f / 1024.0f) + 1e-6f);
          asm volatile("s_waitcnt lgkmcnt(0)" ::: "memory"); __builtin_amdgcn_s_barrier(); asm volatile("" ::: "memory"); }
        const PG8_LAS float* rloc = rtab + wr * 64 + fr;
        f32x4 gv[2][2];
#pragma unroll
        for (int bj = 0; bj < 2; ++bj)
#pragma unroll
            for (int n = 0; n < 2; ++n) gv[bj][n] = *(const f32x4*)(gain + col0 + bj * HALF + n * 4);
#pragma unroll
        for (int ai = 0; ai < 2; ++ai)
#pragma unroll
            for (int m = 0; m < 4; ++m) { const int r = row0 + ai * HALF + m * 16; const float rs = rloc[ai * HALF + m * 16]; const size_t off = (size_t)r * 1024 + col0;
#pragma unroll
                for (int bj = 0; bj < 2; ++bj)
#pragma unroll
                    for (int n = 0; n < 2; ++n) *(f32x4*)(out + off + bj * HALF + n * 4) = acc[ai][bj][m][n] * rs * gv[bj][n]; }
    }
};

template <class Epi, class Sched, bool ALIGN_EPI = false, bool SP2 = false>
__device__ __forceinline__ void gemm_phase(PG8_LAS unsigned char* lds, const Gemm g, const Sched& S, const Epi& E) {
    const int tid = threadIdx.x, wid = __builtin_amdgcn_readfirstlane(tid >> 6), lane = tid & 63, wr = wid >> 2, wc = wid & 3, fr = lane & 15, fq = lane >> 4;
    const int K = g.K, nt = K / BK;
    unsigned voffA[2], voffB[2];
#pragma unroll
    for (int i = 0; i < 2; ++i) { int R, C; stage_rc(tid * 16 + i * 8192, R, C); const int Rb = Epi::PERM ? ((R & ~31) + perm32(R & 31)) : R;
        voffA[i] = (unsigned)(R * K + C) * 2u; voffB[i] = (unsigned)(Rb * K + C) * 2u; }
    const size_t kstep = (size_t)(BK * 2);
    const size_t hstep = (size_t)HALF * K * 2;
    const size_t tstep = 2 * hstep;
    const unsigned ldsw = (unsigned)wid * 1024u;
    const int aoff = lds_byte(wr * 64 + fr, fq * 8), boff = lds_byte(wc * 32 + fr, fq * 8);
#define PG8_SA(b, h) (((b) * 2 + (h)) * HTB)
#define PG8_SB(b, h) ((4 + (b) * 2 + (h)) * HTB)
#define PG8_STAGE(bufoff, gbase, voff) do { _Pragma("unroll") for (int _i = 0; _i < 2; ++_i) \
        __builtin_amdgcn_global_load_lds((const unsigned*)((const char*)(gbase) + (voff)[_i]), (PG8_LAS unsigned*)(lds + (bufoff) + ldsw + _i * 8192), 16, 0, 0); } while (0)
#define PG8_LDA(dst, b, h) do { _Pragma("unroll") for (int m = 0; m < 4; ++m) _Pragma("unroll") for (int k = 0; k < 2; ++k) dst[m][k] = *(const PG8_LAS bf16x8*)(lds + PG8_SA(b, h) + aoff + m * 2048 + k * 1024); } while (0)
#define PG8_LDB(dst, b, h) do { _Pragma("unroll") for (int n = 0; n < 2; ++n) _Pragma("unroll") for (int k = 0; k < 2; ++k) dst[n][k] = *(const PG8_LAS bf16x8*)(lds + PG8_SB(b, h) + boff + n * 2048 + k * 1024); } while (0)
#define PG8_MMA(ai, bj, At, Bt) do { __builtin_amdgcn_s_setprio(1); _Pragma("unroll") for (int m = 0; m < 4; ++m) _Pragma("unroll") for (int n = 0; n < 2; ++n) _Pragma("unroll") for (int k = 0; k < 2; ++k) \
        acc[ai][bj][m][n] = __builtin_amdgcn_mfma_f32_16x16x32_bf16(Bt[n][k], At[m][k], acc[ai][bj][m][n], 0, 0, 0); __builtin_amdgcn_s_setprio(0); } while (0)
#define PG8_WAIT_V(n) asm volatile("s_waitcnt vmcnt(" #n ")" ::: "memory")
#define PG8_WAIT_L(n) asm volatile("s_waitcnt lgkmcnt(" #n ")" ::: "memory")
#define PG8_BAR __builtin_amdgcn_s_barrier()
#define PG8_SCHED __builtin_amdgcn_sched_barrier(0)
    Unit cur, nxt; int ui = 0;
    if (!S.next(0, cur)) return;
    if constexpr (Epi::WANTS_NEXT) E.prefill(cur);
    f32x4 acc[2][2][4][2];
#pragma unroll
    for (int a = 0; a < 2; ++a)
#pragma unroll
        for (int b = 0; b < 2; ++b)
#pragma unroll
            for (int m = 0; m < 4; ++m)
#pragma unroll
                for (int n = 0; n < 2; ++n) acc[a][b][m][n] = (f32x4){0.f, 0.f, 0.f, 0.f};
    bf16x8 At[4][2], B0[2][2], B1[2][2];
    const char* cA = (const char*)g.A + (size_t)cur.pm * tstep; const char* cB = (const char*)g.Bt + (size_t)cur.pn * tstep;
    S.a_ready(cur);
    if constexpr (SP2) {
        PG8_STAGE(PG8_SB(0, 0), cB, voffB); PG8_STAGE(PG8_SB(0, 1), cB + hstep, voffB); PG8_STAGE(PG8_SA(0, 0), cA, voffA); PG8_STAGE(PG8_SA(0, 1), cA + hstep, voffA);
        if (wr == 1) PG8_BAR;
        PG8_WAIT_V(2); PG8_BAR;
        PG8_STAGE(PG8_SB(1, 0), cB + kstep, voffB); PG8_STAGE(PG8_SA(1, 0), cA + kstep, voffA); PG8_STAGE(PG8_SB(1, 1), cB + hstep + kstep, voffB);
        PG8_WAIT_V(6); PG8_BAR;
    } else {
        PG8_STAGE(PG8_SB(0, 0), cB, voffB); PG8_STAGE(PG8_SA(0, 0), cA, voffA); PG8_STAGE(PG8_SB(0, 1), cB + hstep, voffB); PG8_STAGE(PG8_SA(0, 1), cA + hstep, voffA);
        if (wr == 1) PG8_BAR;
        PG8_WAIT_V(4); PG8_BAR;
        PG8_STAGE(PG8_SB(1, 0), cB + kstep, voffB); PG8_STAGE(PG8_SA(1, 0), cA + kstep, voffA); PG8_STAGE(PG8_SB(1, 1), cB + hstep + kstep, voffB);
        PG8_WAIT_V(6); PG8_BAR;
    }
    for (;;) {
        const bool has_next = S.next(ui + 1, nxt);
        const char* nA = has_next ? (const char*)g.A + (size_t)nxt.pm * tstep : cA; const char* nB = has_next ? (const char*)g.Bt + (size_t)nxt.pn * tstep : cB;
        for (int t = 0; t < nt; t += 2) {
            const bool last = (t == nt - 2);
            const char* a1 = cA + (size_t)(t + 1) * kstep;
            const char* a2 = last ? nA : cA + (size_t)(t + 2) * kstep; const char* b2 = last ? nB : cB + (size_t)(t + 2) * kstep;
            const char* a3 = a2 + kstep; const char* b3 = b2 + kstep;
            if (last && has_next) S.a_ready(nxt);
            if constexpr (SP2) {
            PG8_LDB(B0, 0, 0); PG8_LDB(B1, 0, 1); PG8_SCHED; PG8_LDA(At, 0, 0); PG8_STAGE(PG8_SA(1, 1), a1 + hstep, voffA);
            PG8_WAIT_V(8); PG8_WAIT_L(0); PG8_BAR; PG8_MMA(0, 0, At, B0); PG8_MMA(0, 1, At, B1); PG8_BAR; PG8_SCHED;
            PG8_LDA(At, 0, 1); PG8_STAGE(PG8_SB(0, 0), b2, voffB); PG8_STAGE(PG8_SB(0, 1), b2 + hstep, voffB); PG8_STAGE(PG8_SA(0, 0), a2, voffA);
            PG8_WAIT_V(8); PG8_WAIT_L(0); PG8_BAR; PG8_MMA(1, 0, At, B0); PG8_MMA(1, 1, At, B1); PG8_BAR; PG8_SCHED;
            PG8_LDB(B0, 1, 0); PG8_LDB(B1, 1, 1); PG8_SCHED; PG8_LDA(At, 1, 0); PG8_STAGE(PG8_SA(0, 1), a2 + hstep, voffA);
            PG8_WAIT_V(8); PG8_WAIT_L(0); PG8_BAR; PG8_MMA(0, 0, At, B0); PG8_MMA(0, 1, At, B1); PG8_BAR; PG8_SCHED;
            PG8_LDA(At, 1, 1); PG8_STAGE(PG8_SB(1, 0), b3, voffB); PG8_STAGE(PG8_SB(1, 1), b3 + hstep, voffB); PG8_STAGE(PG8_SA(1, 0), a3, voffA);
            PG8_WAIT_V(8); PG8_WAIT_L(0); PG8_BAR; PG8_MMA(1, 0, At, B0); PG8_MMA(1, 1, At, B1); PG8_BAR; PG8_SCHED;
            } else {
            PG8_LDB(B0, 0, 0); PG8_SCHED; PG8_LDA(At, 0, 0); PG8_STAGE(PG8_SA(1, 1), a1 + hstep, voffA);
            PG8_WAIT_L(8); PG8_BAR; PG8_WAIT_L(0); PG8_MMA(0, 0, At, B0); PG8_BAR; PG8_SCHED;
            PG8_LDB(B1, 0, 1); PG8_STAGE(PG8_SB(0, 0), b2, voffB);
            PG8_BAR; PG8_WAIT_L(0); PG8_MMA(0, 1, At, B1); PG8_BAR;
            PG8_LDA(At, 0, 1); PG8_STAGE(PG8_SA(0, 0), a2, voffA);
            PG8_BAR; PG8_WAIT_L(0); PG8_MMA(1, 0, At, B0); PG8_BAR; PG8_SCHED;
            PG8_STAGE(PG8_SB(0, 1), b2 + hstep, voffB);
            PG8_WAIT_V(6); PG8_BAR; PG8_MMA(1, 1, At, B1); PG8_BAR;
            PG8_LDB(B0, 1, 0); PG8_SCHED; PG8_LDA(At, 1, 0); PG8_STAGE(PG8_SA(0, 1), a2 + hstep, voffA);
            PG8_WAIT_L(8); PG8_BAR; PG8_WAIT_L(0); PG8_MMA(0, 0, At, B0); PG8_BAR; PG8_SCHED;
            PG8_LDB(B1, 1, 1); PG8_STAGE(PG8_SB(1, 0), b3, voffB);
            PG8_BAR; PG8_WAIT_L(0); PG8_MMA(0, 1, At, B1); PG8_BAR;
            PG8_LDA(At, 1, 1); PG8_STAGE(PG8_SA(1, 0), a3, voffA);
            PG8_BAR; PG8_WAIT_L(0); PG8_MMA(1, 0, At, B0); PG8_BAR; PG8_SCHED;
            PG8_STAGE(PG8_SB(1, 1), b3 + hstep, voffB);
            PG8_WAIT_V(6); PG8_BAR; PG8_MMA(1, 1, At, B1); PG8_BAR;
            }
        }
        if constexpr (ALIGN_EPI) { if (wr == 0) PG8_BAR; }
        if constexpr (!Epi::AFTER_DRAIN) { if constexpr (Epi::WANTS_NEXT) E(acc, cur, wr, wc, fr, fq, has_next, nxt, ui); else E(acc, cur, wr, wc, fr, fq); S.done(cur); }
        if (!has_next) break;
#pragma unroll
        for (int a = 0; a < 2; ++a)
#pragma unroll
            for (int b = 0; b < 2; ++b)
#pragma unroll
                for (int m = 0; m < 4; ++m)
#pragma unroll
                    for (int n = 0; n < 2; ++n) acc[a][b][m][n] = (f32x4){0.f, 0.f, 0.f, 0.f};
        cur = nxt; cA = nA; cB = nB; ++ui;
        if constexpr (ALIGN_EPI) { if (wr == 1) PG8_BAR; }
    }
    PG8_WAIT_V(0);
    if constexpr (!ALIGN_EPI) { if (wr == 0) PG8_BAR; }
    PG8_BAR;
#undef PG8_SA
#undef PG8_SB
#undef PG8_STAGE
#undef PG8_LDA
#undef PG8_LDB
#undef PG8_MMA
#undef PG8_WAIT_V
#undef PG8_WAIT_L
#undef PG8_BAR
#undef PG8_SCHED
}
}

#define LAS __attribute__((address_space(3)))
typedef unsigned short bf16;
typedef unsigned u32x4 __attribute__((ext_vector_type(4)));
typedef float f32x4 __attribute__((ext_vector_type(4)));
typedef float f32x16 __attribute__((ext_vector_type(16)));
typedef short bf16x8 __attribute__((ext_vector_type(8)));
typedef short s16x4 __attribute__((ext_vector_type(4)));

constexpr int M = 16384, D = 1024, FF = 2816, DIN = 2560, SEQ = 4096, NHEAD = 8, DA = 512, DC = 512;
constexpr int NWAVES = 8;
constexpr size_t MiB = 1u << 20;
constexpr size_t WS_SSQ0 = 1 * MiB, WS_SSQ1 = 2 * MiB, WS_SSQ2 = 3 * MiB, WS_SSQ3 = 4 * MiB;
constexpr size_t WS_WGU1 = 6 * MiB, WS_WD1 = 17 * MiB, WS_WIN = 23 * MiB, WS_WOUT = 28 * MiB, WS_WGU2 = 30 * MiB, WS_WD2 = 41 * MiB;
constexpr size_t WS_XB = 48 * MiB, WS_AC = 80 * MiB, WS_H = 144 * MiB, WS_END = 232 * MiB;
constexpr size_t QKVG_STRIDE = 16 * MiB;
constexpr int LDS_BYTES = 147456;
constexpr float LOG2E = 1.4426950408889634f;
constexpr float QSCALE = 0.125f * LOG2E;

__device__ __forceinline__ unsigned f2bf(float f) { unsigned u = __builtin_bit_cast(unsigned, f); return (u + 0x7fffu + ((u >> 16) & 1u)) >> 16; }
__device__ __forceinline__ unsigned pk2(float lo, float hi) { return pg8::cvt_pk_bf16(lo, hi); }
__device__ __forceinline__ float bf2f(unsigned short b) { return __builtin_bit_cast(float, (unsigned)b << 16); }
__device__ __forceinline__ float wave_sum(float v) {
#pragma unroll
    for (int o = 1; o < 64; o <<= 1) v += __shfl_xor(v, o);
    return v;
}

__device__ __forceinline__ void p0_transpose_item(const float* W, int K, int N, bf16* WT, const float* gain, int k0, int n0, int dest_row0, LAS float* scr, int lane, bool wt = false) {
    const int kr = lane >> 3, nq = lane & 7;
    f32x4 v[8]; float gk[8];
#pragma unroll
    for (int i = 0; i < 8; ++i) { const int kk = 8 * i + kr; v[i] = *(const f32x4*)(W + (size_t)(k0 + kk) * N + n0 + 4 * nq); gk[i] = gain ? gain[k0 + kk] : 1.f; }
#pragma unroll
    for (int i = 0; i < 8; ++i) { LAS float* d = scr + (8 * i + kr) * 33 + 4 * nq; d[0] = v[i].x * gk[i]; d[1] = v[i].y * gk[i]; d[2] = v[i].z * gk[i]; d[3] = v[i].w * gk[i]; }
    const int c = lane & 7;
#pragma unroll
    for (int j = 0; j < 4; ++j) { const int n = (lane >> 3) + 8 * j; const LAS float* s = scr + (8 * c) * 33 + n;
        u32x4 o; o.x = pk2(s[0 * 33], s[1 * 33]); o.y = pk2(s[2 * 33], s[3 * 33]); o.z = pk2(s[4 * 33], s[5 * 33]); o.w = pk2(s[6 * 33], s[7 * 33]);
        bf16* op = WT + (size_t)(dest_row0 + n) * K + k0 + 8 * c;
        if (wt) asm volatile("global_store_dwordx4 %0, %1, off sc1" :: "v"(op), "v"(o) : "memory");
        else *(u32x4*)op = o; }
}
__device__ __forceinline__ int gu_row(int n0, int second) { return (n0 >> 7) * 256 + (n0 & 127) + second * 128; }

struct Ptrs {
    const float *x, *n1, *g1, *u1, *d1, *nm, *win, *relb, *dwk, *dwb, *lng, *lnb, *wout, *n2, *g2, *u2, *d2, *nf;
    float* out; unsigned char* ws;
};

__device__ __forceinline__ void convert_weights(const Ptrs& P, LAS unsigned char* lds, int set, int gw, int NGW, int wave, int lane, bool wt = false) {
    LAS float* scr = (LAS float*)(lds + wave * 16384);
    constexpr int I_GU = (D / 64) * (FF / 32), I_DN = (FF / 64) * (D / 32), I_IN = (D / 64) * (DIN / 32), I_OUT = (D / 64) * (D / 32);
    const int nitems = set == 0 ? 2 * I_GU : set == 1 ? I_DN + I_IN : I_OUT + 2 * I_GU + I_DN;
    for (int it = gw; it < nitems; it += NGW) {
        int r = it;
        if (set == 1) {
            if (r < I_DN) { const int nblk = D / 32, kb = r / nblk, nb = r % nblk;
                p0_transpose_item(P.d1, FF, D, (bf16*)(P.ws + WS_WD1), nullptr, 64 * kb, 32 * nb, 32 * nb, scr, lane, wt); continue; }
            r -= I_DN;
            { const int nblk = DIN / 32, kb = r / nblk, nb = r % nblk, n0 = 32 * nb;
                int drow = n0;
                if (n0 >= 3 * DA) { const int c = (n0 - 3 * DA) & (DC - 1), second = (n0 - 3 * DA) >> 9; drow = 3 * DA + gu_row(c, second); }
                p0_transpose_item(P.win, D, DIN, (bf16*)(P.ws + WS_WIN), P.nm, 64 * kb, n0, drow, scr, lane, wt); continue; }
        }
        if (set == 2) {
            if (r < I_OUT) { const int nblk = D / 32, kb = r / nblk, nb = r % nblk;
                p0_transpose_item(P.wout, D, D, (bf16*)(P.ws + WS_WOUT), nullptr, 64 * kb, 32 * nb, 32 * nb, scr, lane, wt); continue; }
            r -= I_OUT;
            if (r >= 2 * I_GU) { r -= 2 * I_GU; const int nblk = D / 32, kb = r / nblk, nb = r % nblk;
                p0_transpose_item(P.d2, FF, D, (bf16*)(P.ws + WS_WD2), nullptr, 64 * kb, 32 * nb, 32 * nb, scr, lane, wt); continue; }
        }
        {
            const int second = r / I_GU; r -= second * I_GU; const int nblk = FF / 32, kb = r / nblk, nb = r % nblk;
            const float* W = set == 0 ? (second ? P.u1 : P.g1) : (second ? P.u2 : P.g2);
            p0_transpose_item(W, D, FF, (bf16*)(P.ws + (set == 0 ? WS_WGU1 : WS_WGU2)), set == 0 ? P.n1 : P.n2, 64 * kb, 32 * nb, gu_row(32 * nb, second), scr, lane, wt); }
    }
}
__device__ __forceinline__ void p0_prologue(const Ptrs& P, LAS unsigned char* lds, int gw, int NGW, int wave, int lane, bool all_sets) {
    convert_weights(P, lds, 0, gw, NGW, wave, lane);
    if (all_sets) { convert_weights(P, lds, 1, gw, NGW, wave, lane); convert_weights(P, lds, 2, gw, NGW, wave, lane); }
    bf16* XB = (bf16*)(P.ws + WS_XB); float* ssq0 = (float*)(P.ws + WS_SSQ0);
    for (int m = gw; m < M; m += 2 * NGW) {
        const int m1 = m + NGW;
        const bool has1 = m1 < M; const int mm1 = has1 ? m1 : m;
        const f32x4* xr0 = (const f32x4*)(P.x + (size_t)m * D) + lane; const f32x4* xr1 = (const f32x4*)(P.x + (size_t)mm1 * D) + lane;
        f32x4 v0[4], v1[4]; float s0 = 0.f, s1 = 0.f;
#pragma unroll
        for (int j = 0; j < 4; ++j) { v0[j] = xr0[64 * j]; v1[j] = xr1[64 * j]; }
#pragma unroll
        for (int j = 0; j < 4; ++j) { s0 += (v0[j].x * v0[j].x + v0[j].y * v0[j].y) + (v0[j].z * v0[j].z + v0[j].w * v0[j].w); s1 += (v1[j].x * v1[j].x + v1[j].y * v1[j].y) + (v1[j].z * v1[j].z + v1[j].w * v1[j].w); }
        s0 = wave_sum(s0); s1 = wave_sum(s1);
        unsigned long long* o0 = (unsigned long long*)(XB + (size_t)m * D) + lane; unsigned long long* o1 = (unsigned long long*)(XB + (size_t)mm1 * D) + lane;
#pragma unroll
        for (int j = 0; j < 4; ++j) { o0[64 * j] = (unsigned long long)pk2(v0[j].x, v0[j].y) | ((unsigned long long)pk2(v0[j].z, v0[j].w) << 32);
            if (has1) o1[64 * j] = (unsigned long long)pk2(v1[j].x, v1[j].y) | ((unsigned long long)pk2(v1[j].z, v1[j].w) << 32); }
        if (lane < 16) { ssq0[(size_t)m * 16 + lane] = (lane == 0) ? s0 : 0.f; if (has1) ssq0[(size_t)m1 * 16 + lane] = (lane == 0) ? s1 : 0.f; }
    }
}

__device__ __forceinline__ int crow(int r, int hi) { return (r & 3) + 8 * (r >> 2) + 4 * hi; }
typedef short v4i16_t __attribute__((ext_vector_type(4)));
__device__ __forceinline__ s16x4 vtr(const LAS unsigned char* p) { return __builtin_bit_cast(s16x4, __builtin_amdgcn_ds_read_tr16_b64_v4i16((LAS v4i16_t*)p)); }

constexpr int AT_K = 0, AT_V = 16384, AT_WS = 32768, AT_TBL = 34816, AT_OST = 38912, AT_BYTES = AT_OST + NWAVES * 4096;

__device__ __forceinline__ void attn_unit(int b, int h, int grp, const bf16* Q, const bf16* K, const bf16* V, bf16* AC, const float* relb, LAS unsigned char* shm) {
    const int tid = threadIdx.x, lane = tid & 63, r32 = lane & 31, hi = lane >> 5; const int wid = __builtin_amdgcn_readfirstlane(tid >> 6);
    const size_t rowbase = (size_t)b * SEQ;
    const int cq = 4 * grp + (wid >> 1), qi0 = (wid & 1) * 32;
    const size_t qrow0 = rowbase + (size_t)cq * 64 + qi0;
    bf16x8 qr[4];
#pragma unroll
    for (int d0 = 0; d0 < 4; ++d0) qr[d0] = *(const bf16x8*)(Q + (qrow0 + r32) * DA + h * 64 + d0 * 16 + hi * 8);
    LAS float* tbl = (LAS float*)(shm + AT_TBL);
    for (int j = tid; j < 639; j += NWAVES * 64) { const int d = 575 - j; const int idx = (d < 128 ? d : 128) + 128; tbl[j] = relb[idx * NHEAD + h] * LOG2E; }
    LAS float* wsf = (LAS float*)(shm + AT_WS) + wid * 64;
    const int kt_lo = (4 * grp - 8) > 0 ? (4 * grp - 8) : 0, kt_hi = 4 * grp + 3;
    const bf16* ksrc = K + (rowbase + lane) * DA + h * 64 + wid * 8;
    const bf16* vsrc = V + (rowbase + 16 * (wid & 3) + (lane >> 2)) * DA + h * 64 + (wid >> 2) * 32 + (lane & 3) * 8;
    const int stoff = wid * 1024 + lane * 16;
    u32x4 kreg = *(const u32x4*)(ksrc + (size_t)kt_lo * 64 * DA), vreg = *(const u32x4*)(vsrc + (size_t)kt_lo * 64 * DA);
    *(LAS u32x4*)(shm + AT_K + stoff) = kreg; *(LAS u32x4*)(shm + AT_V + stoff) = vreg;
    __syncthreads();
    float mrun = -1e30f, lrun = 0.f; f32x16 o[2];
#pragma unroll
    for (int r = 0; r < 16; ++r) { o[0][r] = 0.f; o[1][r] = 0.f; }
    const int voff = ((lane >> 4) & 1) * 32 + (lane & 3) * 8 + (4 * hi + ((lane & 15) >> 2)) * 64;
    for (int kt = kt_lo; kt <= kt_hi; ++kt) {
        const int buf = (kt - kt_lo) & 1; const bool more = kt < kt_hi;
        if (more) { kreg = *(const u32x4*)(ksrc + (size_t)(kt + 1) * 64 * DA); vreg = *(const u32x4*)(vsrc + (size_t)(kt + 1) * 64 * DA); }
        const int dd = cq - kt;
        if (dd >= 0 && dd <= 8) {
            const LAS unsigned char* kb = shm + AT_K + buf * 8192 + hi * 1024 + r32 * 16;
            bf16x8 kf[8];
#pragma unroll
            for (int d0 = 0; d0 < 4; ++d0) { kf[2 * d0] = *(const LAS bf16x8*)(kb + d0 * 2048); kf[2 * d0 + 1] = *(const LAS bf16x8*)(kb + d0 * 2048 + 512); }
            const LAS float* tb = tbl + (575 - dd * 64 - (qi0 + r32) + 4 * hi);
            f32x16 p0, p1;
#pragma unroll
            for (int r = 0; r < 16; ++r) { p0[r] = tb[(r & 3) + 8 * (r >> 2)]; p1[r] = tb[32 + (r & 3) + 8 * (r >> 2)]; }
            const LAS unsigned char* vb = shm + AT_V + buf * 8192 + voff;
            s16x4 vlo[8], vhi[8];
#pragma unroll
            for (int i = 0; i < 8; ++i) { vlo[i] = vtr(vb + (i >> 2) * 4096 + (i & 3) * 1024); vhi[i] = vtr(vb + (i >> 2) * 4096 + (i & 3) * 1024 + 512); }
#pragma unroll
            for (int d0 = 0; d0 < 4; ++d0) {
                p0 = __builtin_amdgcn_mfma_f32_32x32x16_bf16(kf[2 * d0], qr[d0], p0, 0, 0, 0); p1 = __builtin_amdgcn_mfma_f32_32x32x16_bf16(kf[2 * d0 + 1], qr[d0], p1, 0, 0, 0); }
            float rm = __builtin_fmaxf(p0[0], p1[0]);
#pragma unroll
            for (int r = 1; r < 16; ++r) rm = __builtin_fmaxf(rm, __builtin_fmaxf(p0[r], p1[r]));
            { auto rr = __builtin_amdgcn_permlane32_swap(__float_as_uint(rm), __float_as_uint(rm), false, false); rm = __builtin_fmaxf(__uint_as_float(rr[0]), __uint_as_float(rr[1])); }
            const bool need = rm > mrun + 8.0f;
            if (__any(need)) {
                const float mnew = need ? rm : mrun; const float f = __builtin_amdgcn_exp2f(mrun - mnew); mrun = mnew; lrun *= f;
                if (hi == 0) wsf[r32] = f;
#pragma unroll
                for (int r = 0; r < 16; ++r) { const float fo = wsf[crow(r, hi)]; o[0][r] *= fo; o[1][r] *= fo; }
            }
            float ls = 0.f;
#pragma unroll
            for (int r = 0; r < 16; ++r) { p0[r] = __builtin_amdgcn_exp2f(p0[r] - mrun); p1[r] = __builtin_amdgcn_exp2f(p1[r] - mrun); ls += p0[r] + p1[r]; }
            lrun += ls;
            u32x4 pw0, pw1, pw2, pw3;
            pw0 = (u32x4){pk2(p0[0], p0[1]), pk2(p0[2], p0[3]), pk2(p0[4], p0[5]), pk2(p0[6], p0[7])};
            pw1 = (u32x4){pk2(p0[8], p0[9]), pk2(p0[10], p0[11]), pk2(p0[12], p0[13]), pk2(p0[14], p0[15])};
            pw2 = (u32x4){pk2(p1[0], p1[1]), pk2(p1[2], p1[3]), pk2(p1[4], p1[5]), pk2(p1[6], p1[7])};
            pw3 = (u32x4){pk2(p1[8], p1[9]), pk2(p1[10], p1[11]), pk2(p1[12], p1[13]), pk2(p1[14], p1[15])};
#define VFRAG(i) ((bf16x8){vlo[i][0], vlo[i][1], vlo[i][2], vlo[i][3], vhi[i][0], vhi[i][1], vhi[i][2], vhi[i][3]})
#pragma unroll
            for (int d0 = 0; d0 < 2; ++d0) {
                o[d0] = __builtin_amdgcn_mfma_f32_32x32x16_bf16(__builtin_bit_cast(bf16x8, pw0), VFRAG(d0 * 4 + 0), o[d0], 0, 0, 0);
                o[d0] = __builtin_amdgcn_mfma_f32_32x32x16_bf16(__builtin_bit_cast(bf16x8, pw1), VFRAG(d0 * 4 + 1), o[d0], 0, 0, 0);
                o[d0] = __builtin_amdgcn_mfma_f32_32x32x16_bf16(__builtin_bit_cast(bf16x8, pw2), VFRAG(d0 * 4 + 2), o[d0], 0, 0, 0);
                o[d0] = __builtin_amdgcn_mfma_f32_32x32x16_bf16(__builtin_bit_cast(bf16x8, pw3), VFRAG(d0 * 4 + 3), o[d0], 0, 0, 0);
            }
#undef VFRAG
        }
        if (more) { *(LAS u32x4*)(shm + AT_K + (buf ^ 1) * 8192 + stoff) = kreg; *(LAS u32x4*)(shm + AT_V + (buf ^ 1) * 8192 + stoff) = vreg; }
        __syncthreads();
    }
    { auto rr = __builtin_amdgcn_permlane32_swap(__float_as_uint(lrun), __float_as_uint(lrun), false, false); lrun = __uint_as_float(rr[0]) + __uint_as_float(rr[1]); }
    if (hi == 0) wsf[32 + r32] = lrun;
    LAS bf16* stg = (LAS bf16*)(shm + AT_OST) + wid * 2048;
#pragma unroll
    for (int r = 0; r < 16; ++r) { const int orow = crow(r, hi); const float rl = __builtin_amdgcn_rcpf(wsf[32 + orow]);
        stg[orow * 64 + r32] = (bf16)f2bf(o[0][r] * rl); stg[orow * 64 + 32 + r32] = (bf16)f2bf(o[1][r] * rl); }
    bf16* Ow = AC + qrow0 * D + h * 64;
#pragma unroll
    for (int i = 0; i < 4; ++i) { const int row = i * 8 + (lane >> 3), ch = lane & 7; const u32x4 v = *(const LAS u32x4*)(stg + row * 64 + ch * 8); *(u32x4*)(Ow + (size_t)row * D + ch * 8) = v; }
    __syncthreads();
}

constexpr int CV_IN = 0, CV_OUT = 62 * 1024;
typedef float f32x2 __attribute__((ext_vector_type(2)));
__device__ __forceinline__ void conv_unit(int unit, const bf16* G, const float* dwk, const float* dwb, const float* lng, const float* lnb, bf16* AC, LAS unsigned char* shm) {
    const int tid = threadIdx.x, lane = tid & 63; const int wid = __builtin_amdgcn_readfirstlane(tid >> 6);
    const int b = unit >> 6, c = unit & 63;
    const int cp = tid & 255, tg = tid >> 8;
    f32x2 w[31];
#pragma unroll
    for (int j = 0; j < 31; ++j) w[j] = *(const f32x2*)(dwk + j * DC + 2 * cp);
    const f32x2 bias = *(const f32x2*)(dwb + 2 * cp);
    LAS float* obuf = (LAS float*)(shm + CV_OUT);
    const f32x4 g0 = *(const f32x4*)(lng + lane * 8), g1 = *(const f32x4*)(lng + lane * 8 + 4), b0 = *(const f32x4*)(lnb + lane * 8), b1 = *(const f32x4*)(lnb + lane * 8 + 4);
    for (int half = 0; half < 2; ++half) {
        const int t0 = c * 64 + half * 32;
        { u32x4 v[8];
#pragma unroll
            for (int q = 0; q < 8; ++q) { const int idx = tid + q * (NWAVES * 64), ts = t0 - 30 + (idx >> 6); v[q] = (u32x4){0u, 0u, 0u, 0u};
                if (idx < 62 * 64 && ts >= 0) v[q] = *(const u32x4*)(G + ((size_t)b * SEQ + ts) * DC + (idx & 63) * 8); }
#pragma unroll
            for (int q = 0; q < 8; ++q) { const int idx = tid + q * (NWAVES * 64); if (idx < 62 * 64) *(LAS u32x4*)(shm + CV_IN + idx * 16) = v[q]; } }
        __syncthreads();
#pragma unroll 1
        for (int blk = 0; blk < 2; ++blk) {
            const int i0 = 16 * tg + 8 * blk;
            f32x2 acc[8];
#pragma unroll
            for (int i = 0; i < 8; ++i) acc[i] = bias;
            const LAS unsigned* ip = (const LAS unsigned*)(shm + CV_IN) + i0 * 256 + cp;
#pragma unroll
            for (int k = 0; k < 38; ++k) { const unsigned raw = ip[k * 256]; f32x2 xv; xv.x = __builtin_bit_cast(float, raw << 16); xv.y = __builtin_bit_cast(float, raw & 0xffff0000u);
#pragma unroll
                for (int i = 0; i < 8; ++i) { const int j = k - i; if (j >= 0 && j <= 30) acc[i] += w[j] * xv; } }
#pragma unroll
            for (int i = 0; i < 8; ++i) *(LAS f32x2*)(obuf + (i0 + i) * DC + 2 * cp) = acc[i];
        }
        __syncthreads();
#pragma unroll
        for (int q = 0; q < 4; ++q) { const int i = wid * 4 + q;
            const f32x4 v0 = *(const LAS f32x4*)(obuf + i * DC + lane * 8), v1 = *(const LAS f32x4*)(obuf + i * DC + lane * 8 + 4);
            const float mean = wave_sum((v0[0] + v0[1]) + (v0[2] + v0[3]) + (v1[0] + v1[1]) + (v1[2] + v1[3])) * (1.0f / DC);
            const f32x4 e0 = v0 - mean, e1 = v1 - mean;
            const float var = wave_sum((e0[0] * e0[0] + e0[1] * e0[1]) + (e0[2] * e0[2] + e0[3] * e0[3]) + (e1[0] * e1[0] + e1[1] * e1[1]) + (e1[2] * e1[2] + e1[3] * e1[3])) * (1.0f / DC);
            const float rstd = __builtin_amdgcn_rsqf(var + 1e-6f);
            f32x4 y0 = e0 * rstd * g0 + b0, y1 = e1 * rstd * g1 + b1;
#pragma unroll
            for (int e = 0; e < 4; ++e) { y0[e] = y0[e] * pg8::sigmoidf_fast(y0[e]); y1[e] = y1[e] * pg8::sigmoidf_fast(y1[e]); }
            u32x4 ov; ov.x = pk2(y0[0], y0[1]); ov.y = pk2(y0[2], y0[3]); ov.z = pk2(y1[0], y1[1]); ov.w = pk2(y1[2], y1[3]);
            *(u32x4*)(AC + ((size_t)b * SEQ + t0 + i) * D + DA + lane * 8) = ov; }
        __syncthreads();
    }
}

#define XB_TMO      128
#define XB_XCNT(j)  (256  + 64 * (j))
#define XB_XSUB(j)  (1280 + 64 * (j))
#define XB_XGEN(j)  (2304 + 64 * (j))
#define XB_TOP      3328
#define XB_TOPGEN   3392
#define XCD_BAR_WORDS 3456
#define XB_SPIN_CAP (1u << 18)
__device__ __forceinline__ unsigned xb_ld(unsigned* p)              { return __hip_atomic_load(p, __ATOMIC_RELAXED, __HIP_MEMORY_SCOPE_AGENT); }
__device__ __forceinline__ unsigned xb_add(unsigned* p, unsigned v) { return __hip_atomic_fetch_add(p, v, __ATOMIC_RELAXED, __HIP_MEMORY_SCOPE_AGENT); }
__device__ __forceinline__ unsigned xb_xcc_id() { return (unsigned)__builtin_amdgcn_s_getreg((3 << 11) | 20) & 0xFu; }
#define XB_SPIN(cond, bar) do { unsigned _sp = 0; while (cond) { __builtin_amdgcn_s_sleep(1); \
    if ((++_sp & 255u) == 0u) { if (xb_ld(&(bar)[XB_TMO])) break; if (_sp > XB_SPIN_CAP) { atomicAdd(&(bar)[XB_TMO], 1u); break; } } } } while (0)
struct XcdBarrier { unsigned* bar; unsigned x; volatile LAS unsigned* st; };
__device__ __forceinline__ XcdBarrier xcd_barrier_post(unsigned* bar, volatile LAS unsigned* st) {
    XcdBarrier b; b.bar = bar; b.x = xb_xcc_id(); b.st = st;
    if (threadIdx.x == 0) st[2] = xb_add(&bar[XB_XCNT(b.x)], 1u);
    return b;
}
__device__ __forceinline__ void xcd_barrier_complete(unsigned* bar, unsigned x, unsigned& nloc, unsigned& nx, unsigned& bal) {
    const unsigned G = gridDim.x * gridDim.y * gridDim.z;
    unsigned sum, cnt, mine, sp = 0u;
    for (;;) {
        sum = 0u; cnt = 0u; mine = 0u;
        bal = 1u;
#pragma unroll
        for (unsigned j = 0; j < 16; ++j) { const unsigned c = xb_ld(&bar[XB_XCNT(j)]); sum += c; cnt += (c > 0u) ? 1u : 0u; mine = (j == x) ? c : mine; if (c != ((j < 8u) ? 32u : 0u)) bal = 0u; }
        if (sum == G) break;
        __builtin_amdgcn_s_sleep(1);
        if ((++sp & 255u) == 0u) { if (xb_ld(&bar[XB_TMO])) break; if (sp > XB_SPIN_CAP) { atomicAdd(&bar[XB_TMO], 1u); break; } }
    }
    nloc = mine > 0u ? mine : 1u; nx = cnt > 0u ? cnt : 1u;
}
__device__ __forceinline__ void xcd_barrier(const XcdBarrier& b) {
    asm volatile("s_waitcnt vmcnt(0)" ::: "memory");
    __syncthreads();
    if (threadIdx.x == 0) {
        unsigned* bar = b.bar;
        __builtin_amdgcn_s_waitcnt(0);
        unsigned nloc = b.st[0], nx = b.st[1];
        if (nloc == 0u) { unsigned bal; xcd_barrier_complete(bar, b.x, nloc, nx, bal); b.st[0] = nloc; b.st[1] = nx; b.st[3] = bal; }
        const unsigned old = xb_add(&bar[XB_XSUB(b.x)], 1u);
        const unsigned gen = old / nloc;
        if (old + 1u == (gen + 1u) * nloc) {
            __builtin_amdgcn_fence(__ATOMIC_RELEASE, "agent");
            asm volatile("s_waitcnt vmcnt(0)" ::: "memory");
            const unsigned og = xb_add(&bar[XB_TOP], 1u);
            const unsigned tg = og / nx;
            if (og + 1u == (tg + 1u) * nx) xb_add(&bar[XB_TOPGEN], 1u);
            else XB_SPIN(xb_ld(&bar[XB_TOPGEN]) == tg, bar);
            __builtin_amdgcn_fence(__ATOMIC_ACQUIRE, "agent");
            asm volatile("s_waitcnt vmcnt(0)" ::: "memory");
        } else {
            XB_SPIN(xb_ld(&bar[XB_TOPGEN]) == gen, bar);
            __builtin_amdgcn_fence(__ATOMIC_ACQUIRE, "agent");
            asm volatile("s_waitcnt vmcnt(0)" ::: "memory");
        }
    }
    __syncthreads();
}
__device__ __forceinline__ void xcd_local_barrier(const XcdBarrier& b, unsigned* lw) {
    asm volatile("s_waitcnt vmcnt(0)" ::: "memory");
    __syncthreads();
    if (threadIdx.x == 0) {
        __builtin_amdgcn_s_waitcnt(0);
        unsigned* w = lw + 64 * b.x;
        const unsigned old = xb_add(w, 1u);
        const unsigned target = (old / 32u + 1u) * 32u;
        XB_SPIN(xb_ld(w) < target, b.bar);
        __builtin_amdgcn_fence(__ATOMIC_ACQUIRE, "agent");
        asm volatile("s_waitcnt vmcnt(0)" ::: "memory");
    }
    __syncthreads();
}
__device__ __forceinline__ void xcd_pair_barrier(const XcdBarrier& b, unsigned* lw) {
    asm volatile("s_waitcnt vmcnt(0)" ::: "memory");
    __syncthreads();
    if (threadIdx.x == 0) {
        __builtin_amdgcn_s_waitcnt(0);
        const unsigned old = xb_add(lw + 64 * b.x, 1u);
        if (old == 31u) { if (!(b.x & 1u)) { __builtin_amdgcn_fence(__ATOMIC_RELEASE, "agent"); asm volatile("s_waitcnt vmcnt(0)" ::: "memory"); }
                          xb_add(lw + 64 * (8 + b.x), 1u); }
        XB_SPIN(xb_ld(lw + 64 * (8 + b.x)) == 0u, b.bar);
        if (b.x & 1u) XB_SPIN(xb_ld(lw + 64 * (8 + b.x - 1u)) == 0u, b.bar);
        __builtin_amdgcn_fence(__ATOMIC_ACQUIRE, "agent");
        asm volatile("s_waitcnt vmcnt(0)" ::: "memory");
    }
    __syncthreads();
}
constexpr size_t WS_LBAR = 98304;
constexpr size_t WS_BAR = 65536;
constexpr size_t CTL_ZERO_BYTES = 131072;
constexpr int LDS_MISC = 131072 + 64;
constexpr int LDS_RTAB = 131072 + 1024;

struct Args { const float* in[18]; float* out; unsigned char* ws; int lo, hi, li, pad; };

__global__ void __launch_bounds__(NWAVES * 64, 2) fwd_kernel(Args a) {
    extern __shared__ __attribute__((aligned(16))) unsigned char lds_raw[];
    LAS unsigned char* lds = (LAS unsigned char*)lds_raw;
    cg::grid_group grid = cg::this_grid();
    const int tid = threadIdx.x, lane = tid & 63, wave = __builtin_amdgcn_readfirstlane(tid >> 6);
    const int G = gridDim.x, bx = blockIdx.x;
    const int vcu = (G % 8 == 0) ? (bx % 8) * (G / 8) + bx / 8 : bx;
    Ptrs P;
    P.x = a.in[0]; P.n1 = a.in[1]; P.g1 = a.in[2]; P.u1 = a.in[3]; P.d1 = a.in[4]; P.nm = a.in[5]; P.win = a.in[6]; P.relb = a.in[7]; P.dwk = a.in[8]; P.dwb = a.in[9];
    P.lng = a.in[10]; P.lnb = a.in[11]; P.wout = a.in[12]; P.n2 = a.in[13]; P.g2 = a.in[14]; P.u2 = a.in[15]; P.d2 = a.in[16]; P.nf = a.in[17]; P.out = a.out; P.ws = a.ws;
    unsigned char* ws = a.ws;
    bf16* XB = (bf16*)(ws + WS_XB); bf16* HB = (bf16*)(ws + WS_H);
    unsigned char* ob = (unsigned char*)P.out;
    bf16* QB = (bf16*)ob; bf16* KB = (bf16*)(ob + QKVG_STRIDE); bf16* VB = (bf16*)(ob + 2 * QKVG_STRIDE); bf16* GB = (bf16*)(ob + 3 * QKVG_STRIDE); bf16* AC = (bf16*)(ws + WS_AC);
    float* ssq0 = (float*)(ws + WS_SSQ0); float* ssq1 = (float*)(ws + WS_SSQ1); float* ssq2 = (float*)(ws + WS_SSQ2); float* ssq3 = (float*)(ws + WS_SSQ3);
    const int lo = a.lo, hi = a.hi;
#define IN(k) (lo <= (k) && (k) < hi)
#define SEAM(k) do { if (IN(k) && IN((k) + 1)) xcd_barrier(bar); } while (0)
    if (tid < 4) ((LAS unsigned*)(lds + LDS_MISC))[tid] = 0u;
    __syncthreads();
    XcdBarrier bar = xcd_barrier_post((unsigned*)(ws + WS_BAR) + a.li * XCD_BAR_WORDS, (volatile LAS unsigned*)(lds + LDS_MISC));
    if (hi < 0) grid.sync();

    const bool defer = (G == 256) && lo == 0 && hi == 10;
    if (IN(0)) { p0_prologue(P, lds, vcu * NWAVES + wave, G * NWAVES, wave, lane, !defer); }
    SEAM(0);
    const volatile LAS unsigned* mst = (const volatile LAS unsigned*)(lds + LDS_MISC);
    const bool loc = defer && (mst[3] == 1u) && (bar.x < 8u);
    const int cb = loc ? (int)(mst[2] * 8u + bar.x) : bx;
    unsigned* lbw = (unsigned*)(ws + WS_LBAR);
#define LSEAM(k) do { if (IN(k) && IN((k) + 1)) { if (loc) xcd_local_barrier(bar, lbw); else xcd_barrier(bar); } } while (0)
    if (IN(1)) {
        pg8::Gemm g{XB, (const bf16*)(ws + WS_WGU1), M, 2 * FF, D}; pg8::StaticOrder S; S.init(M, 2 * FF, G, cb);
        pg8::EpiProj<0> E{nullptr, 512, 0, 1.f, 0, HB, FF, ssq0, (LAS float*)(lds + LDS_RTAB)};
        pg8::gemm_phase<pg8::EpiProj<0>, pg8::StaticOrder, true, true>(lds, g, S, E);
        if (defer && cb >= 128) { convert_weights(P, lds, 1, (cb - 128) * NWAVES + wave, 128 * NWAVES, wave, lane, loc);
            if (loc) {
                asm volatile("s_waitcnt vmcnt(0)" ::: "memory"); __syncthreads();
                if (tid == 0) __hip_atomic_fetch_add(lbw + 64 * 8, 1u, __ATOMIC_RELAXED, __HIP_MEMORY_SCOPE_AGENT);
            } }
    }
    if (loc) {
        if (IN(1) && IN(2)) { if (tid == 0) { XB_SPIN(xb_ld(lbw + 64 * 8) < 128u, bar.bar); } xcd_local_barrier(bar, lbw); }
    } else SEAM(1);
    if (IN(2)) {
        pg8::Gemm g{HB, (const bf16*)(ws + WS_WD1), M, D, FF}; pg8::StaticOrder S; S.init(M, D, G, cb);
        pg8::EpiResidW<false> E{P.x, XB, ssq1, 0.5f};
        pg8::gemm_phase<pg8::EpiResidW<false>, pg8::StaticOrder, true, true>(lds, g, S, E);
    }
    LSEAM(2);
    if (IN(3)) {
        pg8::Gemm g{XB, (const bf16*)(ws + WS_WIN), M, DIN, D}; pg8::StaticOrder S; S.init(M, DIN, G, cb);
        pg8::EpiProj<1> E{QB, DA, (size_t)QKVG_STRIDE / 2, QSCALE, 6, GB, DC, ssq1, (LAS float*)(lds + LDS_RTAB)};
        pg8::gemm_phase<pg8::EpiProj<1>, pg8::StaticOrder, true, true>(lds, g, S, E);
        if (defer && cb >= 128) { convert_weights(P, lds, 2, (cb - 128) * NWAVES + wave, 128 * NWAVES, wave, lane, loc);
            if (loc) { asm volatile("s_waitcnt vmcnt(0)" ::: "memory"); __syncthreads(); if (tid == 0) __hip_atomic_fetch_add(lbw + 64 * 9, 1u, __ATOMIC_RELAXED, __HIP_MEMORY_SCOPE_AGENT); } }
    }
    if (loc) {
        if (IN(3) && IN(4)) xcd_pair_barrier(bar, lbw + 64 * 16);
    } else SEAM(3);
    if (IN(4)) {
        if (loc) {
            const int xcd = cb & 7, j = cb >> 3;
            for (int i = 0; i < 2; ++i) { const int idx = j * 2 + i; attn_unit(xcd >> 1, idx & 7, 8 * (xcd & 1) + (idx >> 3), QB, KB, VB, AC, P.relb, lds); }
        } else if (G == 256) {
            const int xcd = cb & 7, j = cb >> 3;
            for (int i = 0; i < 2; ++i) { const int idx = j * 2 + i, bh = xcd * 4 + (idx >> 4), grp = idx & 15; attn_unit(bh >> 3, bh & 7, grp, QB, KB, VB, AC, P.relb, lds); }
        } else {
            for (int u = cb; u < 512; u += G) { const int bh = u >> 4, grp = u & 15; attn_unit(bh >> 3, bh & 7, grp, QB, KB, VB, AC, P.relb, lds); }
        }
    }
    if (IN(5)) {
        if (loc) conv_unit(32 * (cb & 7) + (cb >> 3), GB, P.dwk, P.dwb, P.lng, P.lnb, AC, lds);
        else for (int u = cb; u < M / 64; u += G) conv_unit(u, GB, P.dwk, P.dwb, P.lng, P.lnb, AC, lds);
    }
    if (loc && IN(5) && IN(6) && tid == 0) { XB_SPIN(xb_ld(lbw + 64 * 9) < 128u, bar.bar); }
    LSEAM(5);
    if (loc && IN(5) && IN(6) && tid == 0) xb_add(lbw + 64 * 10, 1u);
    if (IN(6)) {
        pg8::Gemm g{AC, (const bf16*)(ws + WS_WOUT), M, D, D}; pg8::StaticOrder S; S.init(M, D, G, cb);
        pg8::EpiResidW<true> E{XB, XB, ssq2, 1.0f};
        pg8::gemm_phase<pg8::EpiResidW<true>, pg8::StaticOrder, true, true>(lds, g, S, E);
    }
    LSEAM(6);
    if (IN(7)) {
        pg8::Gemm g{XB, (const bf16*)(ws + WS_WGU2), M, 2 * FF, D}; pg8::StaticOrder S; S.init(M, 2 * FF, G, cb);
        pg8::EpiProj<0> E{nullptr, 512, 0, 1.f, 0, HB, FF, ssq2, (LAS float*)(lds + LDS_RTAB)};
        pg8::gemm_phase<pg8::EpiProj<0>, pg8::StaticOrder, true, true>(lds, g, S, E);
    }
    if (loc && IN(7) && IN(8) && tid == 0) { XB_SPIN(xb_ld(lbw + 64 * 10) < (unsigned)G, bar.bar); }
    LSEAM(7);
    if (IN(8)) {
        pg8::Gemm g{HB, (const bf16*)(ws + WS_WD2), M, D, FF}; pg8::StaticOrder S; S.init(M, D, G, cb);
        if (G == 256) {
            pg8::EpiFinal E{XB, P.out, ssq3, (unsigned*)ws, P.nf, 0.5f, (LAS float*)(lds + LDS_RTAB)};
            pg8::gemm_phase<pg8::EpiFinal, pg8::StaticOrder, true, true>(lds, g, S, E);
        } else {
            pg8::EpiResid<true, true> E{XB, P.out, nullptr, ssq3, 0.5f};
            pg8::gemm_phase<pg8::EpiResid<true, true>, pg8::StaticOrder, true, true>(lds, g, S, E);
        }
    }
    if (G != 256) SEAM(8);
    if (IN(9) && G != 256) {
        const int gw = vcu * NWAVES + wave, NGW = G * NWAVES;
        f32x4 gv[4];
#pragma unroll
        for (int j = 0; j < 4; ++j) gv[j] = ((const f32x4*)P.nf)[lane + 64 * j];
        for (int m = gw; m < M; m += 2 * NGW) {
            const int m1 = (m + NGW < M) ? m + NGW : m;
            const float rs0 = pg8::row_rstd(ssq3, m), rs1 = pg8::row_rstd(ssq3, m1);
            f32x4* xr0 = (f32x4*)(P.out + (size_t)m * D) + lane; f32x4* xr1 = (f32x4*)(P.out + (size_t)m1 * D) + lane;
            f32x4 v0[4], v1[4];
#pragma unroll
            for (int j = 0; j < 4; ++j) { v0[j] = xr0[64 * j]; v1[j] = xr1[64 * j]; }
#pragma unroll
            for (int j = 0; j < 4; ++j) { xr0[64 * j] = v0[j] * rs0 * gv[j]; if (m1 != m) xr1[64 * j] = v1[j] * rs1 * gv[j]; }
        }
    }
#undef IN
#undef SEAM
}

#ifndef N_LAUNCH_SPLIT
#define N_LAUNCH_SPLIT 0
#endif

extern "C" void kernel_launch(void* const* d_in, const int* in_sizes, int n_in, void* d_out, int out_size, void* d_ws, size_t ws_size, hipStream_t stream) {
    static int grid = 0;
    if (grid == 0) {
        int dev = 0, cus = 0, per_cu = 0;
        if (n_in != 18 || out_size != M * D || ws_size < WS_END) { fprintf(stderr, "kernel_launch: unexpected shapes (n_in %d out %d ws %zu)\n", n_in, out_size, ws_size); grid = -1; return; }
        hipGetDevice(&dev); hipDeviceGetAttribute(&cus, hipDeviceAttributeMultiprocessorCount, dev);
        if (hipFuncSetAttribute((const void*)fwd_kernel, hipFuncAttributeMaxDynamicSharedMemorySize, LDS_BYTES) != hipSuccess) { fprintf(stderr, "kernel_launch: hipFuncSetAttribute failed\n"); grid = -1; return; }
        if (hipOccupancyMaxActiveBlocksPerMultiprocessor(&per_cu, (const void*)fwd_kernel, NWAVES * 64, LDS_BYTES) != hipSuccess || per_cu < 1) { fprintf(stderr, "kernel_launch: occupancy query says %d\n", per_cu); per_cu = 1; }
        (void)hipGetLastError();
        grid = cus * per_cu;
    }
    if (grid < 0) return;
    if (hipMemsetAsync(d_ws, 0, CTL_ZERO_BYTES, stream) != hipSuccess) { fprintf(stderr, "kernel_launch: memset of the control words failed\n"); return; }
    Args a{};
    for (int i = 0; i < 18; ++i) a.in[i] = (const float*)d_in[i];
    a.out = (float*)d_out; a.ws = (unsigned char*)d_ws;
#if N_LAUNCH_SPLIT
    for (int p = 0; p < 10; ++p) { a.lo = p; a.hi = p + 1; hipLaunchKernelGGL(fwd_kernel, dim3(grid), dim3(NWAVES * 64), LDS_BYTES, stream, a); }
#else
    a.lo = 0; a.hi = 10;
    void* args[] = {&a};
    hipError_t e = hipLaunchCooperativeKernel((const void*)fwd_kernel, dim3(grid), dim3(NWAVES * 64), args, LDS_BYTES, stream);
    if (e != hipSuccess) fprintf(stderr, "cooperative launch failed: %s (grid %d)\n", hipGetErrorString(e), grid);
#endif
}
```

```cpp
#include <hip/hip_runtime.h>
#include <hip/hip_cooperative_groups.h>
#include <cstdio>
#include <cstdint>
namespace cg = cooperative_groups;

namespace pg8 {
#define PG8_LAS __attribute__((address_space(3)))
typedef unsigned short bf16_t;
typedef short bf16x8 __attribute__((ext_vector_type(8)));
typedef float f32x4 __attribute__((ext_vector_type(4)));
typedef unsigned u32x4 __attribute__((ext_vector_type(4)));
typedef unsigned u32x2 __attribute__((ext_vector_type(2)));
constexpr int BM = 256, BK = 64, HALF = 128, HTB = HALF * BK * 2, STAGE_BYTES = 8 * HTB, NXCD = 8, WGM = 8;

__host__ __device__ __forceinline__ int lds_byte(int r, int c) { const int st = (r >> 4) * 2 + (c >> 5), rr = r & 15, cc = c & 31, ob = rr * 64 + cc * 2; return st * 1024 + (ob ^ (((ob >> 9) & 1) << 5)); }
__host__ __device__ __forceinline__ void stage_rc(int b, int& R, int& C) { const int st = b / 1024, sb = b % 1024, swz = sb ^ (((sb >> 9) & 1) << 5); R = (st >> 1) * 16 + swz / 64; C = (st & 1) * 32 + (swz % 64) / 2; }
__host__ __device__ __forceinline__ int perm32(int rho) { const int n = rho >> 4, i = rho & 15; return 8 * (i >> 2) + 4 * n + (i & 3); }

struct Unit { int pm, pn, half; };
struct Gemm { const bf16_t* A; const bf16_t* Bt; int M, N, K; };

struct StaticOrder {
    int nM, nN, nwg, G, c; bool halfmode;
    __host__ __device__ void init(int M, int N, int G_, int c_, bool want_half = false) { nM = M / BM; nN = N / BM; nwg = nM * nN; G = G_; c = c_;
        halfmode = want_half && (G % 16 == 0) && (nwg % NXCD == 0) && (nwg % G == G / 2); }
    __host__ __device__ bool next(int i, Unit& u) const {
        const long L = (long)i * G + c; u.half = 0;
        int wgid;
        const int nfull = nwg - nwg % G;
        if (halfmode && L >= nfull) {
            if (L >= nfull + G) return false;
            const int xcd = (int)(L % NXCD), off = (int)(L / NXCD), hoff = off - nfull / NXCD;
            wgid = xcd * (nwg / NXCD) + nfull / NXCD + (hoff >> 1); u.half = 1 + (hoff & 1);
        } else {
            if (L >= nwg) return false;
            wgid = (int)L; { const int q = nwg / NXCD, r = nwg % NXCD, xcd = wgid % NXCD, off = wgid / NXCD; wgid = (xcd < r ? xcd * (q + 1) : r * (q + 1) + (xcd - r) * q) + off; }
        }
        const int nig = WGM * nN, gid = wgid / nig, fm = gid * WGM, gsz = (nM - fm) < WGM ? (nM - fm) : WGM;
        u.pm = fm + ((wgid % nig) % gsz); u.pn = (wgid % nig) / gsz; return true;
    }
    __device__ __forceinline__ void a_ready(const Unit&) const {}
    __device__ __forceinline__ void done(const Unit&) const {}
};

typedef float f32x2 __attribute__((ext_vector_type(2)));
typedef __bf16 bf16x2_t __attribute__((ext_vector_type(2)));
__device__ __forceinline__ unsigned cvt_pk_bf16(float lo, float hi) { f32x2 v = {lo, hi}; bf16x2_t b = __builtin_convertvector(v, bf16x2_t); return __builtin_bit_cast(unsigned, b); }
__device__ __forceinline__ float sigmoidf_fast(float v) { return __builtin_amdgcn_rcpf(1.0f + __builtin_amdgcn_exp2f(-1.4426950408889634f * v)); }

__device__ __forceinline__ float row_rstd(const float* ssq, int r) {
    const f32x4* p = (const f32x4*)(ssq + (size_t)r * 16);
    const f32x4 a = p[0], b = p[1], c = p[2], d = p[3];
    const float s = ((a[0] + a[1]) + (a[2] + a[3])) + ((b[0] + b[1]) + (b[2] + b[3])) + ((c[0] + c[1]) + (c[2] + c[3])) + ((d[0] + d[1]) + (d[2] + d[3]));
    return __builtin_amdgcn_rsqf(s * (1.0f / 1024.0f) + 1e-6f);
}

template <int KIND> struct EpiProj {
    static constexpr bool PERM = true, AFTER_DRAIN = false;
    bf16_t* Oplain; int split_cols; size_t split_stride; float scale0; int n_plain;
    bf16_t* Ogated; int ldg; const float* ssq; PG8_LAS float* rtab;
    static constexpr bool WANTS_NEXT = true;
    __device__ __forceinline__ void prefill(const Unit& u) const {
        const int t = threadIdx.x, rr = t >> 1, hf = t & 1; const f32x4* p = (const f32x4*)(ssq + (size_t)(u.pm * BM + rr) * 16 + hf * 8); const f32x4 a = p[0], b = p[1];
        float sm = ((a[0] + a[1]) + (a[2] + a[3])) + ((b[0] + b[1]) + (b[2] + b[3])); sm += __shfl_xor(sm, 1);
        if (hf == 0) rtab[rr] = __builtin_amdgcn_rsqf(sm * (1.0f / 1024.0f) + 1e-6f);
        asm volatile("s_waitcnt lgkmcnt(0)" ::: "memory"); __builtin_amdgcn_s_barrier(); asm volatile("" ::: "memory");
    }
    __device__ __forceinline__ void operator()(const f32x4 (&acc)[2][2][4][2], const Unit& u, int wr, int wc, int fr, int fq, bool has_next, const Unit& nxt, int ui) const {
        const int nai = u.half ? 1 : 2, roff = (u.half == 2) ? HALF : 0;
        const int row0 = u.pm * BM + roff + wr * 64 + fr;
        f32x4 na = {0.f, 0.f, 0.f, 0.f}, nb = {0.f, 0.f, 0.f, 0.f};
        const int trr = threadIdx.x >> 1, thf = threadIdx.x & 1;
        if (has_next) { const f32x4* p = (const f32x4*)(ssq + (size_t)(nxt.pm * BM + trr) * 16 + thf * 8); na = p[0]; nb = p[1]; }
        const PG8_LAS float* rloc = rtab + (ui & 1) * 256 + roff + wr * 64 + fr;
        if (u.pn < n_plain) {
            int colt = u.pn * BM; const int t = colt / split_cols; bf16_t* base = Oplain + (size_t)t * split_stride; colt -= t * split_cols;
            const float sc = (t == 0) ? scale0 : 1.f; const int col0 = colt + wc * 32 + 8 * fq;
#pragma unroll
            for (int ai = 0; ai < 2; ++ai) if (ai < nai)
#pragma unroll
                for (int m = 0; m < 4; ++m) { const int r = row0 + ai * HALF + m * 16; const float rs = rloc[ai * HALF + m * 16] * sc; bf16_t* rowp = base + (size_t)r * split_cols + col0;
#pragma unroll
                    for (int bj = 0; bj < 2; ++bj) { const f32x4 v0 = acc[ai][bj][m][0] * rs, v1 = acc[ai][bj][m][1] * rs;
                        u32x4 w; w.x = cvt_pk_bf16(v0[0], v0[1]); w.y = cvt_pk_bf16(v0[2], v0[3]); w.z = cvt_pk_bf16(v1[0], v1[1]); w.w = cvt_pk_bf16(v1[2], v1[3]);
                        *(u32x4*)(rowp + bj * HALF) = w; } }
        } else {
            const int col0 = (u.pn - n_plain) * HALF + wc * 32 + 8 * fq;
#pragma unroll
            for (int ai = 0; ai < 2; ++ai) if (ai < nai)
#pragma unroll
                for (int m = 0; m < 4; ++m) { const int r = row0 + ai * HALF + m * 16; const float rs = rloc[ai * HALF + m * 16];
                    float o[8];
                    const float kx = -1.4426950408889634f * rs, rs2 = rs * rs;
#pragma unroll
                    for (int n = 0; n < 2; ++n)
#pragma unroll
                        for (int e = 0; e < 4; ++e) { const float a = acc[ai][0][m][n][e], b = acc[ai][1][m][n][e];
                            if (KIND == 0) { const float sg = __builtin_amdgcn_rcpf(1.0f + __builtin_amdgcn_exp2f(a * kx)); o[n * 4 + e] = (a * b) * rs2 * sg; }
                            else { const float sg = __builtin_amdgcn_rcpf(1.0f + __builtin_amdgcn_exp2f(b * kx)); o[n * 4 + e] = (a * rs) * sg; } }
                    u32x4 w; w.x = cvt_pk_bf16(o[0], o[1]); w.y = cvt_pk_bf16(o[2], o[3]); w.z = cvt_pk_bf16(o[4], o[5]); w.w = cvt_pk_bf16(o[6], o[7]);
                    *(u32x4*)(Ogated + (size_t)r * ldg + col0) = w; }
        }
        if (has_next) { float sm = ((na[0] + na[1]) + (na[2] + na[3])) + ((nb[0] + nb[1]) + (nb[2] + nb[3])); sm += __shfl_xor(sm, 1);
            if (thf == 0) rtab[((ui + 1) & 1) * 256 + trr] = __builtin_amdgcn_rsqf(sm * (1.0f / 1024.0f) + 1e-6f); }
    }
};

__device__ __forceinline__ f32x4 bf4_to_f32(u32x2 w) { f32x4 r; r[0] = __builtin_bit_cast(float, w.x << 16); r[1] = __builtin_bit_cast(float, w.x & 0xffff0000u); r[2] = __builtin_bit_cast(float, w.y << 16); r[3] = __builtin_bit_cast(float, w.y & 0xffff0000u); return r; }
template <bool BASE_BF16, bool OUT_F32> struct EpiResid {
    static constexpr bool PERM = false, AFTER_DRAIN = false, WANTS_NEXT = false;
    const void* base; float* outf; bf16_t* outb; float* ssq_out; float alpha;
    __device__ __forceinline__ void operator()(const f32x4 (&acc)[2][2][4][2], const Unit& u, int wr, int wc, int fr, int fq) const {
        const int col0 = u.pn * BM + wc * 32 + 4 * fq; const int row0 = u.pm * BM + wr * 64 + fr;
        u32x2 bb[2][4][2][2];
        if constexpr (BASE_BF16) {
#pragma unroll
            for (int ai = 0; ai < 2; ++ai)
#pragma unroll
                for (int m = 0; m < 4; ++m)
#pragma unroll
                    for (int bj = 0; bj < 2; ++bj)
#pragma unroll
                        for (int n = 0; n < 2; ++n) bb[ai][m][bj][n] = *(const u32x2*)((const bf16_t*)base + (size_t)(row0 + ai * HALF + m * 16) * 1024 + col0 + bj * HALF + n * 16);
        }
#pragma unroll
        for (int ai = 0; ai < 2; ++ai) {
            f32x4 bf[4][2][2];
            if constexpr (!BASE_BF16) {
#pragma unroll
                for (int m = 0; m < 4; ++m)
#pragma unroll
                    for (int bj = 0; bj < 2; ++bj)
#pragma unroll
                        for (int n = 0; n < 2; ++n) bf[m][bj][n] = *(const f32x4*)((const float*)base + (size_t)(row0 + ai * HALF + m * 16) * 1024 + col0 + bj * HALF + n * 16);
            }
#pragma unroll
            for (int m = 0; m < 4; ++m) { const int r = row0 + ai * HALF + m * 16; const size_t off = (size_t)r * 1024 + col0; float s = 0.f;
#pragma unroll
                for (int bj = 0; bj < 2; ++bj)
#pragma unroll
                    for (int n = 0; n < 2; ++n) { f32x4 bs; if constexpr (BASE_BF16) bs = bf4_to_f32(bb[ai][m][bj][n]); else bs = bf[m][bj][n];
                        const f32x4 o = bs + acc[ai][bj][m][n] * alpha;
                        s += (o[0] * o[0] + o[1] * o[1]) + (o[2] * o[2] + o[3] * o[3]);
                        if constexpr (OUT_F32) *(f32x4*)(outf + off + bj * HALF + n * 16) = o;
                        else { u32x2 w; w.x = cvt_pk_bf16(o[0], o[1]); w.y = cvt_pk_bf16(o[2], o[3]); *(u32x2*)(outb + off + bj * HALF + n * 16) = w; } }
                s += __shfl_xor(s, 16); s += __shfl_xor(s, 32);
                if (fq == 0) ssq_out[(size_t)r * 16 + u.pn * 4 + wc] = s; }
        }
    }
};

template <bool BASE_BF16> struct EpiResidW {
    static constexpr bool PERM = true, AFTER_DRAIN = false, WANTS_NEXT = false;
    const void* base; bf16_t* outb; float* ssq_out; float alpha;
    __device__ __forceinline__ void operator()(const f32x4 (&acc)[2][2][4][2], const Unit& u, int wr, int wc, int fr, int fq) const {
        const int col0 = u.pn * BM + wc * 32 + 8 * fq; const int row0 = u.pm * BM + wr * 64 + fr;
        if constexpr (BASE_BF16) {
            u32x4 bb[2][4][2];
#pragma unroll
            for (int ai = 0; ai < 2; ++ai)
#pragma unroll
                for (int m = 0; m < 4; ++m)
#pragma unroll
                    for (int bj = 0; bj < 2; ++bj) bb[ai][m][bj] = *(const u32x4*)((const bf16_t*)base + (size_t)(row0 + ai * HALF + m * 16) * 1024 + col0 + bj * HALF);
#pragma unroll
            for (int ai = 0; ai < 2; ++ai)
#pragma unroll
                for (int m = 0; m < 4; ++m) { const int r = row0 + ai * HALF + m * 16; const size_t off = (size_t)r * 1024 + col0; float s = 0.f;
#pragma unroll
                    for (int bj = 0; bj < 2; ++bj) {
                        const f32x4 b0 = bf4_to_f32((u32x2){bb[ai][m][bj].x, bb[ai][m][bj].y}), b1 = bf4_to_f32((u32x2){bb[ai][m][bj].z, bb[ai][m][bj].w});
                        const f32x4 o0 = b0 + acc[ai][bj][m][0] * alpha, o1 = b1 + acc[ai][bj][m][1] * alpha;
                        s += ((o0[0] * o0[0] + o0[1] * o0[1]) + (o0[2] * o0[2] + o0[3] * o0[3])) + ((o1[0] * o1[0] + o1[1] * o1[1]) + (o1[2] * o1[2] + o1[3] * o1[3]));
                        u32x4 w; w.x = cvt_pk_bf16(o0[0], o0[1]); w.y = cvt_pk_bf16(o0[2], o0[3]); w.z = cvt_pk_bf16(o1[0], o1[1]); w.w = cvt_pk_bf16(o1[2], o1[3]);
                        *(u32x4*)(outb + off + bj * HALF) = w; }
                    s += __shfl_xor(s, 16); s += __shfl_xor(s, 32);
                    if (fq == 0) ssq_out[(size_t)r * 16 + u.pn * 4 + wc] = s; }
        } else {
            f32x4 cur[2][2][2], nx[2][2][2];
#define PG8_LDQ(dst, q) do { _Pragma("unroll") for (int mm = 0; mm < 2; ++mm) _Pragma("unroll") for (int bj = 0; bj < 2; ++bj) _Pragma("unroll") for (int n = 0; n < 2; ++n) \
                dst[mm][bj][n] = *(const f32x4*)((const float*)base + (size_t)(row0 + ((q) >> 1) * HALF + (((q) & 1) * 2 + mm) * 16) * 1024 + col0 + bj * HALF + n * 4); } while (0)
            PG8_LDQ(cur, 0);
#pragma unroll
            for (int q = 0; q < 4; ++q) {
                if (q < 3) PG8_LDQ(nx, q + 1);
                const int ai = q >> 1;
#pragma unroll
                for (int mm = 0; mm < 2; ++mm) { const int m = (q & 1) * 2 + mm; const int r = row0 + ai * HALF + m * 16; const size_t off = (size_t)r * 1024 + col0; float s = 0.f;
#pragma unroll
                    for (int bj = 0; bj < 2; ++bj) {
                        const f32x4 o0 = cur[mm][bj][0] + acc[ai][bj][m][0] * alpha, o1 = cur[mm][bj][1] + acc[ai][bj][m][1] * alpha;
                        s += ((o0[0] * o0[0] + o0[1] * o0[1]) + (o0[2] * o0[2] + o0[3] * o0[3])) + ((o1[0] * o1[0] + o1[1] * o1[1]) + (o1[2] * o1[2] + o1[3] * o1[3]));
                        u32x4 w; w.x = cvt_pk_bf16(o0[0], o0[1]); w.y = cvt_pk_bf16(o0[2], o0[3]); w.z = cvt_pk_bf16(o1[0], o1[1]); w.w = cvt_pk_bf16(o1[2], o1[3]);
                        *(u32x4*)(outb + off + bj * HALF) = w; }
                    s += __shfl_xor(s, 16); s += __shfl_xor(s, 32);
                    if (fq == 0) ssq_out[(size_t)r * 16 + u.pn * 4 + wc] = s; }
#pragma unroll
                for (int mm = 0; mm < 2; ++mm)
#pragma unroll
                    for (int bj = 0; bj < 2; ++bj)
#pragma unroll
                        for (int n = 0; n < 2; ++n) cur[mm][bj][n] = nx[mm][bj][n];
            }
#undef PG8_LDQ
        }
    }
};

struct EpiFinal {
    static constexpr bool PERM = true, AFTER_DRAIN = false, WANTS_NEXT = false;
    const bf16_t* base; float* out; float* ssq; unsigned* cnt; const float* gain; float alpha; PG8_LAS float* rtab;
    __device__ __forceinline__ void operator()(f32x4 (&acc)[2][2][4][2], const Unit& u, int wr, int wc, int fr, int fq) const {
        const int col0 = u.pn * BM + wc * 32 + 8 * fq; const int row0 = u.pm * BM + wr * 64 + fr;
        u32x4 bb[2][4][2];
#pragma unroll
        for (int ai = 0; ai < 2; ++ai)
#pragma unroll
            for (int m = 0; m < 4; ++m)
#pragma unroll
                for (int bj = 0; bj < 2; ++bj) bb[ai][m][bj] = *(const u32x4*)(base + (size_t)(row0 + ai * HALF + m * 16) * 1024 + col0 + bj * HALF);
#pragma unroll
        for (int ai = 0; ai < 2; ++ai)
#pragma unroll
            for (int m = 0; m < 4; ++m) { const int r = row0 + ai * HALF + m * 16; float s = 0.f;
#pragma unroll
                for (int bj = 0; bj < 2; ++bj)
#pragma unroll
                    for (int n = 0; n < 2; ++n) { const f32x4 o = bf4_to_f32(n ? (u32x2){bb[ai][m][bj].z, bb[ai][m][bj].w} : (u32x2){bb[ai][m][bj].x, bb[ai][m][bj].y}) + acc[ai][bj][m][n] * alpha; acc[ai][bj][m][n] = o;
                        s += (o[0] * o[0] + o[1] * o[1]) + (o[2] * o[2] + o[3] * o[3]); }
                s += __shfl_xor(s, 16); s += __shfl_xor(s, 32);
                if (fq == 0) __hip_atomic_store(ssq + (size_t)r * 16 + u.pn * 4 + wc, s, __ATOMIC_RELAXED, __HIP_MEMORY_SCOPE_AGENT); }
        asm volatile("s_waitcnt vmcnt(0)" ::: "memory");
        unsigned* c = cnt + 64 * u.pm;
        if ((threadIdx.x & 63) == 0) __hip_atomic_fetch_add(c, 1u, __ATOMIC_RELAXED, __HIP_MEMORY_SCOPE_AGENT);
        if (__builtin_amdgcn_readfirstlane(threadIdx.x >> 6) == 0) {
            unsigned spins = 0;
            while ((unsigned)__builtin_amdgcn_readfirstlane(__hip_atomic_load(c, __ATOMIC_RELAXED, __HIP_MEMORY_SCOPE_AGENT)) < 32u) { __builtin_amdgcn_s_sleep(2); if (++spins > (1u << 22)) break; }
            __builtin_amdgcn_fence(__ATOMIC_ACQUIRE, "agent"); asm volatile("s_waitcnt vmcnt(0)" ::: "memory");
        }
        __builtin_amdgcn_s_barrier(); asm volatile("" ::: "memory");
        { const int t = threadIdx.x, rr = t >> 1, hf = t & 1; const f32x4* p = (const f32x4*)(ssq + (size_t)(u.pm * BM + rr) * 16 + hf * 8); const f32x4 a = p[0], b = p[1];
          float sm = ((a[0] + a[1]) + (a[2] + a[3])) + ((b[0] + b[1]) + (b[2] + b[3])); sm += __shfl_xor(sm, 1);
          if (hf == 0) rtab[rr] = __builtin_amdgcn_rsqf(sm * (1.0f / 1024.0f) + 1e-6f);
          asm volatile("s_waitcnt lgkmcnt(0)" ::: "memory"); __builtin_amdgcn_s_barrier(); asm volatile("" ::: "memory"); }
        const PG8_LAS float* rloc = rtab + wr * 64 + fr;
        f32x4 gv[2][2];
#pragma unroll
        for (int bj = 0; bj < 2; ++bj)
#pragma unroll
            for (int n = 0; n < 2; ++n) gv[bj][n] = *(const f32x4*)(gain + col0 + bj * HALF + n * 4);
#pragma unroll
        for (int ai = 0; ai < 2; ++ai)
#pragma unroll
            for (int m = 0; m < 4; ++m) { const int r = row0 + ai * HALF + m * 16; const float rs = rloc[ai * HALF + m * 16]; const size_t off = (size_t)r * 1024 + col0;
#pragma unroll
                for (int bj = 0; bj < 2; ++bj)
#pragma unroll
                    for (int n = 0; n < 2; ++n) *(f32x4*)(out + off + bj * HALF + n * 4) = acc[ai][bj][m][n] * rs * gv[bj][n]; }
    }
};

template <class Epi, class Sched, bool ALIGN_EPI = false, bool SP2 = false>
__device__ __forceinline__ void gemm_phase(PG8_LAS unsigned char* lds, const Gemm g, const Sched& S, const Epi& E) {
    const int tid = threadIdx.x, wid = __builtin_amdgcn_readfirstlane(tid >> 6), lane = tid & 63, wr = wid >> 2, wc = wid & 3, fr = lane & 15, fq = lane >> 4;
    const int K = g.K, nt = K / BK;
    unsigned voffA[2], voffB[2];
#pragma unroll
    for (int i = 0; i < 2; ++i) { int R, C; stage_rc(tid * 16 + i * 8192, R, C); const int Rb = Epi::PERM ? ((R & ~31) + perm32(R & 31)) : R;
        voffA[i] = (unsigned)(R * K + C) * 2u; voffB[i] = (unsigned)(Rb * K + C) * 2u; }
    const size_t kstep = (size_t)(BK * 2);
    const size_t hstep = (size_t)HALF * K * 2;
    const size_t tstep = 2 * hstep;
    const unsigned ldsw = (unsigned)wid * 1024u;
    const int aoff = lds_byte(wr * 64 + fr, fq * 8), boff = lds_byte(wc * 32 + fr, fq * 8);
#define PG8_SA(b, h) (((b) * 2 + (h)) * HTB)
#define PG8_SB(b, h) ((4 + (b) * 2 + (h)) * HTB)
#define PG8_STAGE(bufoff, gbase, voff) do { _Pragma("unroll") for (int _i = 0; _i < 2; ++_i) \
        __builtin_amdgcn_global_load_lds((const unsigned*)((const char*)(gbase) + (voff)[_i]), (PG8_LAS unsigned*)(lds + (bufoff) + ldsw + _i * 8192), 16, 0, 0); } while (0)
#define PG8_LDA(dst, b, h) do { _Pragma("unroll") for (int m = 0; m < 4; ++m) _Pragma("unroll") for (int k = 0; k < 2; ++k) dst[m][k] = *(const PG8_LAS bf16x8*)(lds + PG8_SA(b, h) + aoff + m * 2048 + k * 1024); } while (0)
#define PG8_LDB(dst, b, h) do { _Pragma("unroll") for (int n = 0; n < 2; ++n) _Pragma("unroll") for (int k = 0; k < 2; ++k) dst[n][k] = *(const PG8_LAS bf16x8*)(lds + PG8_SB(b, h) + boff + n * 2048 + k * 1024); } while (0)
#define PG8_MMA(ai, bj, At, Bt) do { __builtin_amdgcn_s_setprio(1); _Pragma("unroll") for (int m = 0; m < 4; ++m) _Pragma("unroll") for (int n = 0; n < 2; ++n) _Pragma("unroll") for (int k = 0; k < 2; ++k) \
        acc[ai][bj][m][n] = __builtin_amdgcn_mfma_f32_16x16x32_bf16(Bt[n][k], At[m][k], acc[ai][bj][m][n], 0, 0, 0); __builtin_amdgcn_s_setprio(0); } while (0)
#define PG8_WAIT_V(n) asm volatile("s_waitcnt vmcnt(" #n ")" ::: "memory")
#define PG8_WAIT_L(n) asm volatile("s_waitcnt lgkmcnt(" #n ")" ::: "memory")
#define PG8_BAR __builtin_amdgcn_s_barrier()
#define PG8_SCHED __builtin_amdgcn_sched_barrier(0)
    Unit cur, nxt; int ui = 0;
    if (!S.next(0, cur)) return;
    if constexpr (Epi::WANTS_NEXT) E.prefill(cur);
    f32x4 acc[2][2][4][2];
#pragma unroll
    for (int a = 0; a < 2; ++a)
#pragma unroll
        for (int b = 0; b < 2; ++b)
#pragma unroll
            for (int m = 0; m < 4; ++m)
#pragma unroll
                for (int n = 0; n < 2; ++n) acc[a][b][m][n] = (f32x4){0.f, 0.f, 0.f, 0.f};
    bf16x8 At[4][2], B0[2][2], B1[2][2];
    const char* cA = (const char*)g.A + (size_t)cur.pm * tstep + (cur.half == 2 ? hstep : 0); const char* cB = (const char*)g.Bt + (size_t)cur.pn * tstep;
    S.a_ready(cur);
    if constexpr (SP2) {
        PG8_STAGE(PG8_SB(0, 0), cB, voffB); PG8_STAGE(PG8_SB(0, 1), cB + hstep, voffB); PG8_STAGE(PG8_SA(0, 0), cA, voffA); PG8_STAGE(PG8_SA(0, 1), cA + hstep, voffA);
        if (wr == 1) PG8_BAR;
        PG8_WAIT_V(2); PG8_BAR;
        PG8_STAGE(PG8_SB(1, 0), cB + kstep, voffB); PG8_STAGE(PG8_SA(1, 0), cA + kstep, voffA); PG8_STAGE(PG8_SB(1, 1), cB + hstep + kstep, voffB);
        PG8_WAIT_V(6); PG8_BAR;
    } else {
        PG8_STAGE(PG8_SB(0, 0), cB, voffB); PG8_STAGE(PG8_SA(0, 0), cA, voffA); PG8_STAGE(PG8_SB(0, 1), cB + hstep, voffB); PG8_STAGE(PG8_SA(0, 1), cA + hstep, voffA);
        if (wr == 1) PG8_BAR;
        PG8_WAIT_V(4); PG8_BAR;
        PG8_STAGE(PG8_SB(1, 0), cB + kstep, voffB); PG8_STAGE(PG8_SA(1, 0), cA + kstep, voffA); PG8_STAGE(PG8_SB(1, 1), cB + hstep + kstep, voffB);
        PG8_WAIT_V(6); PG8_BAR;
    }
    for (;;) {
        const bool has_next = S.next(ui + 1, nxt);
        const char* nA = has_next ? (const char*)g.A + (size_t)nxt.pm * tstep + (nxt.half == 2 ? hstep : 0) : cA; const char* nB = has_next ? (const char*)g.Bt + (size_t)nxt.pn * tstep : cB;
        for (int t = 0; t < nt; t += 2) {
            const bool last = (t == nt - 2);
            const char* a1 = cA + (size_t)(t + 1) * kstep;
            const char* a2 = last ? nA : cA + (size_t)(t + 2) * kstep; const char* b2 = last ? nB : cB + (size_t)(t + 2) * kstep;
            const char* a3 = a2 + kstep; const char* b3 = b2 + kstep;
            if (last && has_next) S.a_ready(nxt);
            if constexpr (SP2) {
            PG8_LDB(B0, 0, 0); PG8_LDB(B1, 0, 1); PG8_SCHED; PG8_LDA(At, 0, 0); PG8_STAGE(PG8_SA(1, 1), a1 + hstep, voffA);
            PG8_WAIT_V(8); PG8_WAIT_L(0); PG8_BAR; PG8_MMA(0, 0, At, B0); PG8_MMA(0, 1, At, B1); PG8_BAR; PG8_SCHED;
            PG8_LDA(At, 0, 1); PG8_STAGE(PG8_SB(0, 0), b2, voffB); PG8_STAGE(PG8_SB(0, 1), b2 + hstep, voffB); PG8_STAGE(PG8_SA(0, 0), a2, voffA);
            PG8_WAIT_V(8); PG8_WAIT_L(0); PG8_BAR; if (!cur.half) { PG8_MMA(1, 0, At, B0); PG8_MMA(1, 1, At, B1); } PG8_BAR; PG8_SCHED;
            PG8_LDB(B0, 1, 0); PG8_LDB(B1, 1, 1); PG8_SCHED; PG8_LDA(At, 1, 0); PG8_STAGE(PG8_SA(0, 1), a2 + hstep, voffA);
            PG8_WAIT_V(8); PG8_WAIT_L(0); PG8_BAR; PG8_MMA(0, 0, At, B0); PG8_MMA(0, 1, At, B1); PG8_BAR; PG8_SCHED;
            PG8_LDA(At, 1, 1); PG8_STAGE(PG8_SB(1, 0), b3, voffB); PG8_STAGE(PG8_SB(1, 1), b3 + hstep, voffB); PG8_STAGE(PG8_SA(1, 0), a3, voffA);
            PG8_WAIT_V(8); PG8_WAIT_L(0); PG8_BAR; if (!cur.half) { PG8_MMA(1, 0, At, B0); PG8_MMA(1, 1, At, B1); } PG8_BAR; PG8_SCHED;
            } else {
            PG8_LDB(B0, 0, 0); PG8_SCHED; PG8_LDA(At, 0, 0); PG8_STAGE(PG8_SA(1, 1), a1 + hstep, voffA);
            PG8_WAIT_L(8); PG8_BAR; PG8_WAIT_L(0); PG8_MMA(0, 0, At, B0); PG8_BAR; PG8_SCHED;
            PG8_LDB(B1, 0, 1); PG8_STAGE(PG8_SB(0, 0), b2, voffB);
            PG8_BAR; PG8_WAIT_L(0); PG8_MMA(0, 1, At, B1); PG8_BAR;
            PG8_LDA(At, 0, 1); PG8_STAGE(PG8_SA(0, 0), a2, voffA);
            PG8_BAR; PG8_WAIT_L(0); PG8_MMA(1, 0, At, B0); PG8_BAR; PG8_SCHED;
            PG8_STAGE(PG8_SB(0, 1), b2 + hstep, voffB);
            PG8_WAIT_V(6); PG8_BAR; PG8_MMA(1, 1, At, B1); PG8_BAR;
            PG8_LDB(B0, 1, 0); PG8_SCHED; PG8_LDA(At, 1, 0); PG8_STAGE(PG8_SA(0, 1), a2 + hstep, voffA);
            PG8_WAIT_L(8); PG8_BAR; PG8_WAIT_L(0); PG8_MMA(0, 0, At, B0); PG8_BAR; PG8_SCHED;
            PG8_LDB(B1, 1, 1); PG8_STAGE(PG8_SB(1, 0), b3, voffB);
            PG8_BAR; PG8_WAIT_L(0); PG8_MMA(0, 1, At, B1); PG8_BAR;
            PG8_LDA(At, 1, 1); PG8_STAGE(PG8_SA(1, 0), a3, voffA);
            PG8_BAR; PG8_WAIT_L(0); PG8_MMA(1, 0, At, B0); PG8_BAR; PG8_SCHED;
            PG8_STAGE(PG8_SB(1, 1), b3 + hstep, voffB);
            PG8_WAIT_V(6); PG8_BAR; PG8_MMA(1, 1, At, B1); PG8_BAR;
            }
        }
        if constexpr (ALIGN_EPI) { if (wr == 0) PG8_BAR; }
        if constexpr (!Epi::AFTER_DRAIN) { if constexpr (Epi::WANTS_NEXT) E(acc, cur, wr, wc, fr, fq, has_next, nxt, ui); else E(acc, cur, wr, wc, fr, fq); S.done(cur); }
        if (!has_next) break;
#pragma unroll
        for (int a = 0; a < 2; ++a)
#pragma unroll
            for (int b = 0; b < 2; ++b)
#pragma unroll
                for (int m = 0; m < 4; ++m)
#pragma unroll
                    for (int n = 0; n < 2; ++n) acc[a][b][m][n] = (f32x4){0.f, 0.f, 0.f, 0.f};
        cur = nxt; cA = nA; cB = nB; ++ui;
        if constexpr (ALIGN_EPI) { if (wr == 1) PG8_BAR; }
    }
    PG8_WAIT_V(0);
    if constexpr (!ALIGN_EPI) { if (wr == 0) PG8_BAR; }
    PG8_BAR;
#undef PG8_SA
#undef PG8_SB
#undef PG8_STAGE
#undef PG8_LDA
#undef PG8_LDB
#undef PG8_MMA
#undef PG8_WAIT_V
#undef PG8_WAIT_L
#undef PG8_BAR
#undef PG8_SCHED
}
}

#define LAS __attribute__((address_space(3)))
typedef unsigned short bf16;
typedef unsigned u32x4 __attribute__((ext_vector_type(4)));
typedef float f32x4 __attribute__((ext_vector_type(4)));
typedef float f32x16 __attribute__((ext_vector_type(16)));
typedef short bf16x8 __attribute__((ext_vector_type(8)));
typedef short s16x4 __attribute__((ext_vector_type(4)));

constexpr int M = 16384, D = 1024, FF = 2816, DIN = 2560, SEQ = 4096, NHEAD = 8, DA = 512, DC = 512;
constexpr int NWAVES = 8;
constexpr size_t MiB = 1u << 20;
constexpr size_t WS_SSQ0 = 1 * MiB, WS_SSQ1 = 2 * MiB, WS_SSQ2 = 3 * MiB, WS_SSQ3 = 4 * MiB;
constexpr size_t WS_WGU1 = 6 * MiB, WS_WD1 = 17 * MiB, WS_WIN = 23 * MiB, WS_WOUT = 28 * MiB, WS_WGU2 = 30 * MiB, WS_WD2 = 41 * MiB;
constexpr size_t WS_XB = 48 * MiB, WS_AC = 80 * MiB, WS_H = 144 * MiB, WS_END = 232 * MiB;
constexpr size_t QKVG_STRIDE = 16 * MiB;
constexpr int LDS_BYTES = 147456;
constexpr float LOG2E = 1.4426950408889634f;
constexpr float QSCALE = 0.125f * LOG2E;

__device__ __forceinline__ unsigned f2bf(float f) { unsigned u = __builtin_bit_cast(unsigned, f); return (u + 0x7fffu + ((u >> 16) & 1u)) >> 16; }
__device__ __forceinline__ unsigned pk2(float lo, float hi) { return pg8::cvt_pk_bf16(lo, hi); }
__device__ __forceinline__ float bf2f(unsigned short b) { return __builtin_bit_cast(float, (unsigned)b << 16); }
__device__ __forceinline__ float wave_sum(float v) {
#pragma unroll
    for (int o = 1; o < 64; o <<= 1) v += __shfl_xor(v, o);
    return v;
}

__device__ __forceinline__ void p0_transpose_item(const float* W, int K, int N, bf16* WT, const float* gain, int k0, int n0, int dest_row0, LAS float* scr, int lane, bool wt = false) {
    const int kr = lane >> 3, nq = lane & 7;
    f32x4 v[8]; float gk[8];
#pragma unroll
    for (int i = 0; i < 8; ++i) { const int kk = 8 * i + kr; v[i] = *(const f32x4*)(W + (size_t)(k0 + kk) * N + n0 + 4 * nq); gk[i] = gain ? gain[k0 + kk] : 1.f; }
#pragma unroll
    for (int i = 0; i < 8; ++i) { LAS float* d = scr + (8 * i + kr) * 33 + 4 * nq; d[0] = v[i].x * gk[i]; d[1] = v[i].y * gk[i]; d[2] = v[i].z * gk[i]; d[3] = v[i].w * gk[i]; }
    const int c = lane & 7;
#pragma unroll
    for (int j = 0; j < 4; ++j) { const int n = (lane >> 3) + 8 * j; const LAS float* s = scr + (8 * c) * 33 + n;
        u32x4 o; o.x = pk2(s[0 * 33], s[1 * 33]); o.y = pk2(s[2 * 33], s[3 * 33]); o.z = pk2(s[4 * 33], s[5 * 33]); o.w = pk2(s[6 * 33], s[7 * 33]);
        bf16* op = WT + (size_t)(dest_row0 + n) * K + k0 + 8 * c;
        if (wt) asm volatile("global_store_dwordx4 %0, %1, off sc1" :: "v"(op), "v"(o) : "memory");
        else *(u32x4*)op = o; }
}
__device__ __forceinline__ int gu_row(int n0, int second) { return (n0 >> 7) * 256 + (n0 & 127) + second * 128; }

struct Ptrs {
    const float *x, *n1, *g1, *u1, *d1, *nm, *win, *relb, *dwk, *dwb, *lng, *lnb, *wout, *n2, *g2, *u2, *d2, *nf;
    float* out; unsigned char* ws;
};

__device__ __forceinline__ void convert_weights(const Ptrs& P, LAS unsigned char* lds, int set, int gw, int NGW, int wave, int lane, bool wt = false) {
    LAS float* scr = (LAS float*)(lds + wave * 16384);
    constexpr int I_GU = (D / 64) * (FF / 32), I_DN = (FF / 64) * (D / 32), I_IN = (D / 64) * (DIN / 32), I_OUT = (D / 64) * (D / 32);
    const int nitems = set == 0 ? 2 * I_GU : set == 1 ? I_DN + I_IN : I_OUT + 2 * I_GU + I_DN;
    for (int it = gw; it < nitems; it += NGW) {
        int r = it;
        if (set == 1) {
            if (r < I_DN) { const int nblk = D / 32, kb = r / nblk, nb = r % nblk;
                p0_transpose_item(P.d1, FF, D, (bf16*)(P.ws + WS_WD1), nullptr, 64 * kb, 32 * nb, 32 * nb, scr, lane, wt); continue; }
            r -= I_DN;
            { const int nblk = DIN / 32, kb = r / nblk, nb = r % nblk, n0 = 32 * nb;
                int drow = n0;
                if (n0 >= 3 * DA) { const int c = (n0 - 3 * DA) & (DC - 1), second = (n0 - 3 * DA) >> 9; drow = 3 * DA + gu_row(c, second); }
                p0_transpose_item(P.win, D, DIN, (bf16*)(P.ws + WS_WIN), P.nm, 64 * kb, n0, drow, scr, lane, wt); continue; }
        }
        if (set == 2) {
            if (r < I_OUT) { const int nblk = D / 32, kb = r / nblk, nb = r % nblk;
                p0_transpose_item(P.wout, D, D, (bf16*)(P.ws + WS_WOUT), nullptr, 64 * kb, 32 * nb, 32 * nb, scr, lane, wt); continue; }
            r -= I_OUT;
            if (r >= 2 * I_GU) { r -= 2 * I_GU; const int nblk = D / 32, kb = r / nblk, nb = r % nblk;
                p0_transpose_item(P.d2, FF, D, (bf16*)(P.ws + WS_WD2), nullptr, 64 * kb, 32 * nb, 32 * nb, scr, lane, wt); continue; }
        }
        {
            const int second = r / I_GU; r -= second * I_GU; const int nblk = FF / 32, kb = r / nblk, nb = r % nblk;
            const float* W = set == 0 ? (second ? P.u1 : P.g1) : (second ? P.u2 : P.g2);
            p0_transpose_item(W, D, FF, (bf16*)(P.ws + (set == 0 ? WS_WGU1 : WS_WGU2)), set == 0 ? P.n1 : P.n2, 64 * kb, 32 * nb, gu_row(32 * nb, second), scr, lane, wt); }
    }
}
__device__ __forceinline__ void p0_prologue(const Ptrs& P, LAS unsigned char* lds, int gw, int NGW, int wave, int lane, bool all_sets) {
    convert_weights(P, lds, 0, gw, NGW, wave, lane);
    if (all_sets) { convert_weights(P, lds, 1, gw, NGW, wave, lane); convert_weights(P, lds, 2, gw, NGW, wave, lane); }
    bf16* XB = (bf16*)(P.ws + WS_XB); float* ssq0 = (float*)(P.ws + WS_SSQ0);
    for (int m = gw; m < M; m += 2 * NGW) {
        const int m1 = m + NGW;
        const bool has1 = m1 < M; const int mm1 = has1 ? m1 : m;
        const f32x4* xr0 = (const f32x4*)(P.x + (size_t)m * D) + lane; const f32x4* xr1 = (const f32x4*)(P.x + (size_t)mm1 * D) + lane;
        f32x4 v0[4], v1[4]; float s0 = 0.f, s1 = 0.f;
#pragma unroll
        for (int j = 0; j < 4; ++j) { v0[j] = xr0[64 * j]; v1[j] = xr1[64 * j]; }
#pragma unroll
        for (int j = 0; j < 4; ++j) { s0 += (v0[j].x * v0[j].x + v0[j].y * v0[j].y) + (v0[j].z * v0[j].z + v0[j].w * v0[j].w); s1 += (v1[j].x * v1[j].x + v1[j].y * v1[j].y) + (v1[j].z * v1[j].z + v1[j].w * v1[j].w); }
        s0 = wave_sum(s0); s1 = wave_sum(s1);
        unsigned long long* o0 = (unsigned long long*)(XB + (size_t)m * D) + lane; unsigned long long* o1 = (unsigned long long*)(XB + (size_t)mm1 * D) + lane;
#pragma unroll
        for (int j = 0; j < 4; ++j) { o0[64 * j] = (unsigned long long)pk2(v0[j].x, v0[j].y) | ((unsigned long long)pk2(v0[j].z, v0[j].w) << 32);
            if (has1) o1[64 * j] = (unsigned long long)pk2(v1[j].x, v1[j].y) | ((unsigned long long)pk2(v1[j].z, v1[j].w) << 32); }
        if (lane < 16) { ssq0[(size_t)m * 16 + lane] = (lane == 0) ? s0 : 0.f; if (has1) ssq0[(size_t)m1 * 16 + lane] = (lane == 0) ? s1 : 0.f; }
    }
}

__device__ __forceinline__ int crow(int r, int hi) { return (r & 3) + 8 * (r >> 2) + 4 * hi; }
typedef short v4i16_t __attribute__((ext_vector_type(4)));
__device__ __forceinline__ s16x4 vtr(const LAS unsigned char* p) { return __builtin_bit_cast(s16x4, __builtin_amdgcn_ds_read_tr16_b64_v4i16((LAS v4i16_t*)p)); }

constexpr int AT_K = 0, AT_V = 16384, AT_WS = 32768, AT_TBL = 34816, AT_OST = 38912, AT_BYTES = AT_OST + NWAVES * 4096;

__device__ __forceinline__ void attn_unit(int b, int h, int grp, const bf16* Q, const bf16* K, const bf16* V, bf16* AC, const float* relb, LAS unsigned char* shm) {
    const int tid = threadIdx.x, lane = tid & 63, r32 = lane & 31, hi = lane >> 5; const int wid = __builtin_amdgcn_readfirstlane(tid >> 6);
    const size_t rowbase = (size_t)b * SEQ;
    const int cq = 4 * grp + (wid >> 1), qi0 = (wid & 1) * 32;
    const size_t qrow0 = rowbase + (size_t)cq * 64 + qi0;
    bf16x8 qr[4];
#pragma unroll
    for (int d0 = 0; d0 < 4; ++d0) qr[d0] = *(const bf16x8*)(Q + (qrow0 + r32) * DA + h * 64 + d0 * 16 + hi * 8);
    LAS float* tbl = (LAS float*)(shm + AT_TBL);
    for (int j = tid; j < 639; j += NWAVES * 64) { const int d = 575 - j; const int idx = (d < 128 ? d : 128) + 128; tbl[j] = relb[idx * NHEAD + h] * LOG2E; }
    LAS float* wsf = (LAS float*)(shm + AT_WS) + wid * 64;
    const int kt_lo = (4 * grp - 8) > 0 ? (4 * grp - 8) : 0, kt_hi = 4 * grp + 3;
    const bf16* ksrc = K + (rowbase + lane) * DA + h * 64 + wid * 8;
    const bf16* vsrc = V + (rowbase + 16 * (wid & 3) + (lane >> 2)) * DA + h * 64 + (wid >> 2) * 32 + (lane & 3) * 8;
    const int stoff = wid * 1024 + lane * 16;
    u32x4 kreg = *(const u32x4*)(ksrc + (size_t)kt_lo * 64 * DA), vreg = *(const u32x4*)(vsrc + (size_t)kt_lo * 64 * DA);
    *(LAS u32x4*)(shm + AT_K + stoff) = kreg; *(LAS u32x4*)(shm + AT_V + stoff) = vreg;
    __syncthreads();
    float mrun = -1e30f, lrun = 0.f; f32x16 o[2];
#pragma unroll
    for (int r = 0; r < 16; ++r) { o[0][r] = 0.f; o[1][r] = 0.f; }
    const int voff = ((lane >> 4) & 1) * 32 + (lane & 3) * 8 + (4 * hi + ((lane & 15) >> 2)) * 64;
    for (int kt = kt_lo; kt <= kt_hi; ++kt) {
        const int buf = (kt - kt_lo) & 1; const bool more = kt < kt_hi;
        if (more) { kreg = *(const u32x4*)(ksrc + (size_t)(kt + 1) * 64 * DA); vreg = *(const u32x4*)(vsrc + (size_t)(kt + 1) * 64 * DA); }
        const int dd = cq - kt;
        if (dd >= 0 && dd <= 8) {
            const LAS unsigned char* kb = shm + AT_K + buf * 8192 + hi * 1024 + r32 * 16;
            bf16x8 kf[8];
#pragma unroll
            for (int d0 = 0; d0 < 4; ++d0) { kf[2 * d0] = *(const LAS bf16x8*)(kb + d0 * 2048); kf[2 * d0 + 1] = *(const LAS bf16x8*)(kb + d0 * 2048 + 512); }
            const LAS float* tb = tbl + (575 - dd * 64 - (qi0 + r32) + 4 * hi);
            f32x16 p0, p1;
#pragma unroll
            for (int r = 0; r < 16; ++r) { p0[r] = tb[(r & 3) + 8 * (r >> 2)]; p1[r] = tb[32 + (r & 3) + 8 * (r >> 2)]; }
            const LAS unsigned char* vb = shm + AT_V + buf * 8192 + voff;
            s16x4 vlo[8], vhi[8];
#pragma unroll
            for (int i = 0; i < 8; ++i) { vlo[i] = vtr(vb + (i >> 2) * 4096 + (i & 3) * 1024); vhi[i] = vtr(vb + (i >> 2) * 4096 + (i & 3) * 1024 + 512); }
#pragma unroll
            for (int d0 = 0; d0 < 4; ++d0) {
                p0 = __builtin_amdgcn_mfma_f32_32x32x16_bf16(kf[2 * d0], qr[d0], p0, 0, 0, 0); p1 = __builtin_amdgcn_mfma_f32_32x32x16_bf16(kf[2 * d0 + 1], qr[d0], p1, 0, 0, 0); }
            float rm = __builtin_fmaxf(p0[0], p1[0]);
#pragma unroll
            for (int r = 1; r < 16; ++r) rm = __builtin_fmaxf(rm, __builtin_fmaxf(p0[r], p1[r]));
            { auto rr = __builtin_amdgcn_permlane32_swap(__float_as_uint(rm), __float_as_uint(rm), false, false); rm = __builtin_fmaxf(__uint_as_float(rr[0]), __uint_as_float(rr[1])); }
            const bool need = rm > mrun + 8.0f;
            if (__any(need)) {
                const float mnew = need ? rm : mrun; const float f = __builtin_amdgcn_exp2f(mrun - mnew); mrun = mnew; lrun *= f;
                if (hi == 0) wsf[r32] = f;
#pragma unroll
                for (int r = 0; r < 16; ++r) { const float fo = wsf[crow(r, hi)]; o[0][r] *= fo; o[1][r] *= fo; }
            }
            float ls = 0.f;
#pragma unroll
            for (int r = 0; r < 16; ++r) { p0[r] = __builtin_amdgcn_exp2f(p0[r] - mrun); p1[r] = __builtin_amdgcn_exp2f(p1[r] - mrun); ls += p0[r] + p1[r]; }
            lrun += ls;
            u32x4 pw0, pw1, pw2, pw3;
            pw0 = (u32x4){pk2(p0[0], p0[1]), pk2(p0[2], p0[3]), pk2(p0[4], p0[5]), pk2(p0[6], p0[7])};
            pw1 = (u32x4){pk2(p0[8], p0[9]), pk2(p0[10], p0[11]), pk2(p0[12], p0[13]), pk2(p0[14], p0[15])};
            pw2 = (u32x4){pk2(p1[0], p1[1]), pk2(p1[2], p1[3]), pk2(p1[4], p1[5]), pk2(p1[6], p1[7])};
            pw3 = (u32x4){pk2(p1[8], p1[9]), pk2(p1[10], p1[11]), pk2(p1[12], p1[13]), pk2(p1[14], p1[15])};
#define VFRAG(i) ((bf16x8){vlo[i][0], vlo[i][1], vlo[i][2], vlo[i][3], vhi[i][0], vhi[i][1], vhi[i][2], vhi[i][3]})
#pragma unroll
            for (int d0 = 0; d0 < 2; ++d0) {
                o[d0] = __builtin_amdgcn_mfma_f32_32x32x16_bf16(__builtin_bit_cast(bf16x8, pw0), VFRAG(d0 * 4 + 0), o[d0], 0, 0, 0);
                o[d0] = __builtin_amdgcn_mfma_f32_32x32x16_bf16(__builtin_bit_cast(bf16x8, pw1), VFRAG(d0 * 4 + 1), o[d0], 0, 0, 0);
                o[d0] = __builtin_amdgcn_mfma_f32_32x32x16_bf16(__builtin_bit_cast(bf16x8, pw2), VFRAG(d0 * 4 + 2), o[d0], 0, 0, 0);
                o[d0] = __builtin_amdgcn_mfma_f32_32x32x16_bf16(__builtin_bit_cast(bf16x8, pw3), VFRAG(d0 * 4 + 3), o[d0], 0, 0, 0);
            }
#undef VFRAG
        }
        if (more) { *(LAS u32x4*)(shm + AT_K + (buf ^ 1) * 8192 + stoff) = kreg; *(LAS u32x4*)(shm + AT_V + (buf ^ 1) * 8192 + stoff) = vreg; }
        __syncthreads();
    }
    { auto rr = __builtin_amdgcn_permlane32_swap(__float_as_uint(lrun), __float_as_uint(lrun), false, false); lrun = __uint_as_float(rr[0]) + __uint_as_float(rr[1]); }
    if (hi == 0) wsf[32 + r32] = lrun;
    LAS bf16* stg = (LAS bf16*)(shm + AT_OST) + wid * 2048;
#pragma unroll
    for (int r = 0; r < 16; ++r) { const int orow = crow(r, hi); const float rl = __builtin_amdgcn_rcpf(wsf[32 + orow]);
        stg[orow * 64 + r32] = (bf16)f2bf(o[0][r] * rl); stg[orow * 64 + 32 + r32] = (bf16)f2bf(o[1][r] * rl); }
    bf16* Ow = AC + qrow0 * D + h * 64;
#pragma unroll
    for (int i = 0; i < 4; ++i) { const int row = i * 8 + (lane >> 3), ch = lane & 7; const u32x4 v = *(const LAS u32x4*)(stg + row * 64 + ch * 8); *(u32x4*)(Ow + (size_t)row * D + ch * 8) = v; }
    __syncthreads();
}

constexpr int CV_IN = 0, CV_OUT = 62 * 1024;
typedef float f32x2 __attribute__((ext_vector_type(2)));
__device__ __forceinline__ void conv_unit(int unit, const bf16* G, const float* dwk, const float* dwb, const float* lng, const float* lnb, bf16* AC, LAS unsigned char* shm) {
    const int tid = threadIdx.x, lane = tid & 63; const int wid = __builtin_amdgcn_readfirstlane(tid >> 6);
    const int b = unit >> 6, c = unit & 63;
    const int cp = tid & 255, tg = tid >> 8;
    f32x2 w[31];
#pragma unroll
    for (int j = 0; j < 31; ++j) w[j] = *(const f32x2*)(dwk + j * DC + 2 * cp);
    const f32x2 bias = *(const f32x2*)(dwb + 2 * cp);
    LAS float* obuf = (LAS float*)(shm + CV_OUT);
    const f32x4 g0 = *(const f32x4*)(lng + lane * 8), g1 = *(const f32x4*)(lng + lane * 8 + 4), b0 = *(const f32x4*)(lnb + lane * 8), b1 = *(const f32x4*)(lnb + lane * 8 + 4);
    for (int half = 0; half < 2; ++half) {
        const int t0 = c * 64 + half * 32;
        { u32x4 v[8];
#pragma unroll
            for (int q = 0; q < 8; ++q) { const int idx = tid + q * (NWAVES * 64), ts = t0 - 30 + (idx >> 6); v[q] = (u32x4){0u, 0u, 0u, 0u};
                if (idx < 62 * 64 && ts >= 0) v[q] = *(const u32x4*)(G + ((size_t)b * SEQ + ts) * DC + (idx & 63) * 8); }
#pragma unroll
            for (int q = 0; q < 8; ++q) { const int idx = tid + q * (NWAVES * 64); if (idx < 62 * 64) *(LAS u32x4*)(shm + CV_IN + idx * 16) = v[q]; } }
        __syncthreads();
#pragma unroll 1
        for (int blk = 0; blk < 2; ++blk) {
            const int i0 = 16 * tg + 8 * blk;
            f32x2 acc[8];
#pragma unroll
            for (int i = 0; i < 8; ++i) acc[i] = bias;
            const LAS unsigned* ip = (const LAS unsigned*)(shm + CV_IN) + i0 * 256 + cp;
#pragma unroll
            for (int k = 0; k < 38; ++k) { const unsigned raw = ip[k * 256]; f32x2 xv; xv.x = __builtin_bit_cast(float, raw << 16); xv.y = __builtin_bit_cast(float, raw & 0xffff0000u);
#pragma unroll
                for (int i = 0; i < 8; ++i) { const int j = k - i; if (j >= 0 && j <= 30) acc[i] += w[j] * xv; } }
#pragma unroll
            for (int i = 0; i < 8; ++i) *(LAS f32x2*)(obuf + (i0 + i) * DC + 2 * cp) = acc[i];
        }
        __syncthreads();
#pragma unroll
        for (int q = 0; q < 4; ++q) { const int i = wid * 4 + q;
            const f32x4 v0 = *(const LAS f32x4*)(obuf + i * DC + lane * 8), v1 = *(const LAS f32x4*)(obuf + i * DC + lane * 8 + 4);
            const float mean = wave_sum((v0[0] + v0[1]) + (v0[2] + v0[3]) + (v1[0] + v1[1]) + (v1[2] + v1[3])) * (1.0f / DC);
            const f32x4 e0 = v0 - mean, e1 = v1 - mean;
            const float var = wave_sum((e0[0] * e0[0] + e0[1] * e0[1]) + (e0[2] * e0[2] + e0[3] * e0[3]) + (e1[0] * e1[0] + e1[1] * e1[1]) + (e1[2] * e1[2] + e1[3] * e1[3])) * (1.0f / DC);
            const float rstd = __builtin_amdgcn_rsqf(var + 1e-6f);
            f32x4 y0 = e0 * rstd * g0 + b0, y1 = e1 * rstd * g1 + b1;
#pragma unroll
            for (int e = 0; e < 4; ++e) { y0[e] = y0[e] * pg8::sigmoidf_fast(y0[e]); y1[e] = y1[e] * pg8::sigmoidf_fast(y1[e]); }
            u32x4 ov; ov.x = pk2(y0[0], y0[1]); ov.y = pk2(y0[2], y0[3]); ov.z = pk2(y1[0], y1[1]); ov.w = pk2(y1[2], y1[3]);
            *(u32x4*)(AC + ((size_t)b * SEQ + t0 + i) * D + DA + lane * 8) = ov; }
        __syncthreads();
    }
}

#define XB_TMO      128
#define XB_XCNT(j)  (256  + 64 * (j))
#define XB_XSUB(j)  (1280 + 64 * (j))
#define XB_XGEN(j)  (2304 + 64 * (j))
#define XB_TOP      3328
#define XB_TOPGEN   3392
#define XCD_BAR_WORDS 3456
#define XB_SPIN_CAP (1u << 18)
__device__ __forceinline__ unsigned xb_ld(unsigned* p)              { return __hip_atomic_load(p, __ATOMIC_RELAXED, __HIP_MEMORY_SCOPE_AGENT); }
__device__ __forceinline__ unsigned xb_add(unsigned* p, unsigned v) { return __hip_atomic_fetch_add(p, v, __ATOMIC_RELAXED, __HIP_MEMORY_SCOPE_AGENT); }
__device__ __forceinline__ unsigned xb_xcc_id() { return (unsigned)__builtin_amdgcn_s_getreg((3 << 11) | 20) & 0xFu; }
#define XB_SPIN(cond, bar) do { unsigned _sp = 0; while (cond) { __builtin_amdgcn_s_sleep(1); \
    if ((++_sp & 255u) == 0u) { if (xb_ld(&(bar)[XB_TMO])) break; if (_sp > XB_SPIN_CAP) { atomicAdd(&(bar)[XB_TMO], 1u); break; } } } } while (0)
struct XcdBarrier { unsigned* bar; unsigned x; volatile LAS unsigned* st; };
__device__ __forceinline__ XcdBarrier xcd_barrier_post(unsigned* bar, volatile LAS unsigned* st) {
    XcdBarrier b; b.bar = bar; b.x = xb_xcc_id(); b.st = st;
    if (threadIdx.x == 0) st[2] = xb_add(&bar[XB_XCNT(b.x)], 1u);
    return b;
}
__device__ __forceinline__ void xcd_barrier_complete(unsigned* bar, unsigned x, unsigned& nloc, unsigned& nx, unsigned& bal) {
    const unsigned G = gridDim.x * gridDim.y * gridDim.z;
    unsigned sum, cnt, mine, sp = 0u;
    for (;;) {
        sum = 0u; cnt = 0u; mine = 0u;
        bal = 1u;
#pragma unroll
        for (unsigned j = 0; j < 16; ++j) { const unsigned c = xb_ld(&bar[XB_XCNT(j)]); sum += c; cnt += (c > 0u) ? 1u : 0u; mine = (j == x) ? c : mine; if (c != ((j < 8u) ? 32u : 0u)) bal = 0u; }
        if (sum == G) break;
        __builtin_amdgcn_s_sleep(1);
        if ((++sp & 255u) == 0u) { if (xb_ld(&bar[XB_TMO])) break; if (sp > XB_SPIN_CAP) { atomicAdd(&bar[XB_TMO], 1u); break; } }
    }
    nloc = mine > 0u ? mine : 1u; nx = cnt > 0u ? cnt : 1u;
}
__device__ __forceinline__ void xcd_barrier(const XcdBarrier& b) {
    asm volatile("s_waitcnt vmcnt(0)" ::: "memory");
    __syncthreads();
    if (threadIdx.x == 0) {
        unsigned* bar = b.bar;
        __builtin_amdgcn_s_waitcnt(0);
        unsigned nloc = b.st[0], nx = b.st[1];
        if (nloc == 0u) { unsigned bal; xcd_barrier_complete(bar, b.x, nloc, nx, bal); b.st[0] = nloc; b.st[1] = nx; b.st[3] = bal; }
        const unsigned old = xb_add(&bar[XB_XSUB(b.x)], 1u);
        const unsigned gen = old / nloc;
        if (old + 1u == (gen + 1u) * nloc) {
            __builtin_amdgcn_fence(__ATOMIC_RELEASE, "agent");
            asm volatile("s_waitcnt vmcnt(0)" ::: "memory");
            const unsigned og = xb_add(&bar[XB_TOP], 1u);
            const unsigned tg = og / nx;
            if (og + 1u == (tg + 1u) * nx) xb_add(&bar[XB_TOPGEN], 1u);
            else XB_SPIN(xb_ld(&bar[XB_TOPGEN]) == tg, bar);
            __builtin_amdgcn_fence(__ATOMIC_ACQUIRE, "agent");
            asm volatile("s_waitcnt vmcnt(0)" ::: "memory");
        } else {
            XB_SPIN(xb_ld(&bar[XB_TOPGEN]) == gen, bar);
            __builtin_amdgcn_fence(__ATOMIC_ACQUIRE, "agent");
            asm volatile("s_waitcnt vmcnt(0)" ::: "memory");
        }
    }
    __syncthreads();
}
__device__ __forceinline__ void xcd_local_barrier(const XcdBarrier& b, unsigned* lw) {
    asm volatile("s_waitcnt vmcnt(0)" ::: "memory");
    __syncthreads();
    if (threadIdx.x == 0) {
        __builtin_amdgcn_s_waitcnt(0);
        unsigned* w = lw + 64 * b.x;
        const unsigned old = xb_add(w, 1u);
        const unsigned target = (old / 32u + 1u) * 32u;
        XB_SPIN(xb_ld(w) < target, b.bar);
        __builtin_amdgcn_fence(__ATOMIC_ACQUIRE, "agent");
        asm volatile("s_waitcnt vmcnt(0)" ::: "memory");
    }
    __syncthreads();
}
__device__ __forceinline__ void xcd_pair_barrier(const XcdBarrier& b, unsigned* lw) {
    asm volatile("s_waitcnt vmcnt(0)" ::: "memory");
    __syncthreads();
    if (threadIdx.x == 0) {
        __builtin_amdgcn_s_waitcnt(0);
        const unsigned old = xb_add(lw + 64 * b.x, 1u);
        if (old == 31u) { if (!(b.x & 1u)) { __builtin_amdgcn_fence(__ATOMIC_RELEASE, "agent"); asm volatile("s_waitcnt vmcnt(0)" ::: "memory"); }
                          xb_add(lw + 64 * (8 + b.x), 1u); }
        XB_SPIN(xb_ld(lw + 64 * (8 + b.x)) == 0u, b.bar);
        if (b.x & 1u) XB_SPIN(xb_ld(lw + 64 * (8 + b.x - 1u)) == 0u, b.bar);
        __builtin_amdgcn_fence(__ATOMIC_ACQUIRE, "agent");
        asm volatile("s_waitcnt vmcnt(0)" ::: "memory");
    }
    __syncthreads();
}
constexpr size_t WS_LBAR = 98304;
constexpr size_t WS_BAR = 65536;
constexpr size_t CTL_ZERO_BYTES = 131072;
constexpr int LDS_MISC = 131072 + 64;
constexpr int LDS_RTAB = 131072 + 1024;

struct Args { const float* in[18]; float* out; unsigned char* ws; int lo, hi, li, pad; };

__global__ void __launch_bounds__(NWAVES * 64, 2) fwd_kernel(Args a) {
    extern __shared__ __attribute__((aligned(16))) unsigned char lds_raw[];
    LAS unsigned char* lds = (LAS unsigned char*)lds_raw;
    cg::grid_group grid = cg::this_grid();
    const int tid = threadIdx.x, lane = tid & 63, wave = __builtin_amdgcn_readfirstlane(tid >> 6);
    const int G = gridDim.x, bx = blockIdx.x;
    const int vcu = (G % 8 == 0) ? (bx % 8) * (G / 8) + bx / 8 : bx;
    Ptrs P;
    P.x = a.in[0]; P.n1 = a.in[1]; P.g1 = a.in[2]; P.u1 = a.in[3]; P.d1 = a.in[4]; P.nm = a.in[5]; P.win = a.in[6]; P.relb = a.in[7]; P.dwk = a.in[8]; P.dwb = a.in[9];
    P.lng = a.in[10]; P.lnb = a.in[11]; P.wout = a.in[12]; P.n2 = a.in[13]; P.g2 = a.in[14]; P.u2 = a.in[15]; P.d2 = a.in[16]; P.nf = a.in[17]; P.out = a.out; P.ws = a.ws;
    unsigned char* ws = a.ws;
    bf16* XB = (bf16*)(ws + WS_XB); bf16* HB = (bf16*)(ws + WS_H);
    unsigned char* ob = (unsigned char*)P.out;
    bf16* QB = (bf16*)ob; bf16* KB = (bf16*)(ob + QKVG_STRIDE); bf16* VB = (bf16*)(ob + 2 * QKVG_STRIDE); bf16* GB = (bf16*)(ob + 3 * QKVG_STRIDE); bf16* AC = (bf16*)(ws + WS_AC);
    float* ssq0 = (float*)(ws + WS_SSQ0); float* ssq1 = (float*)(ws + WS_SSQ1); float* ssq2 = (float*)(ws + WS_SSQ2); float* ssq3 = (float*)(ws + WS_SSQ3);
    const int lo = a.lo, hi = a.hi;
#define IN(k) (lo <= (k) && (k) < hi)
#define SEAM(k) do { if (IN(k) && IN((k) + 1)) xcd_barrier(bar); } while (0)
    if (tid < 4) ((LAS unsigned*)(lds + LDS_MISC))[tid] = 0u;
    __syncthreads();
    XcdBarrier bar = xcd_barrier_post((unsigned*)(ws + WS_BAR) + a.li * XCD_BAR_WORDS, (volatile LAS unsigned*)(lds + LDS_MISC));
    if (hi < 0) grid.sync();

    const bool defer = (G == 256) && lo == 0 && hi == 10;
    if (IN(0)) { p0_prologue(P, lds, vcu * NWAVES + wave, G * NWAVES, wave, lane, !defer); }
    SEAM(0);
    const volatile LAS unsigned* mst = (const volatile LAS unsigned*)(lds + LDS_MISC);
    const bool loc = defer && (mst[3] == 1u) && (bar.x < 8u);
    const int cb = loc ? (int)(mst[2] * 8u + bar.x) : bx;
    unsigned* lbw = (unsigned*)(ws + WS_LBAR);
#define LSEAM(k) do { if (IN(k) && IN((k) + 1)) { if (loc) xcd_local_barrier(bar, lbw); else xcd_barrier(bar); } } while (0)
    if (IN(1)) {
        pg8::Gemm g{XB, (const bf16*)(ws + WS_WGU1), M, 2 * FF, D}; pg8::StaticOrder S; S.init(M, 2 * FF, G, cb);
        pg8::EpiProj<0> E{nullptr, 512, 0, 1.f, 0, HB, FF, ssq0, (LAS float*)(lds + LDS_RTAB)};
        pg8::gemm_phase<pg8::EpiProj<0>, pg8::StaticOrder, true, true>(lds, g, S, E);
        if (defer && cb >= 128) { convert_weights(P, lds, 1, (cb - 128) * NWAVES + wave, 128 * NWAVES, wave, lane, loc);
            if (loc) {
                asm volatile("s_waitcnt vmcnt(0)" ::: "memory"); __syncthreads();
                if (tid == 0) __hip_atomic_fetch_add(lbw + 64 * 8, 1u, __ATOMIC_RELAXED, __HIP_MEMORY_SCOPE_AGENT);
            } }
    }
    if (loc) {
        if (IN(1) && IN(2)) { if (tid == 0) { XB_SPIN(xb_ld(lbw + 64 * 8) < 128u, bar.bar); } xcd_local_barrier(bar, lbw); }
    } else SEAM(1);
    if (IN(2)) {
        pg8::Gemm g{HB, (const bf16*)(ws + WS_WD1), M, D, FF}; pg8::StaticOrder S; S.init(M, D, G, cb);
        pg8::EpiResidW<false> E{P.x, XB, ssq1, 0.5f};
        pg8::gemm_phase<pg8::EpiResidW<false>, pg8::StaticOrder, true, true>(lds, g, S, E);
    }
    LSEAM(2);
    if (IN(3)) {
        pg8::Gemm g{XB, (const bf16*)(ws + WS_WIN), M, DIN, D}; pg8::StaticOrder S; S.init(M, DIN, G, cb);
        pg8::EpiProj<1> E{QB, DA, (size_t)QKVG_STRIDE / 2, QSCALE, 6, GB, DC, ssq1, (LAS float*)(lds + LDS_RTAB)};
        pg8::gemm_phase<pg8::EpiProj<1>, pg8::StaticOrder, true, true>(lds, g, S, E);
        if (defer && cb >= 128) { convert_weights(P, lds, 2, (cb - 128) * NWAVES + wave, 128 * NWAVES, wave, lane, loc);
            if (loc) { asm volatile("s_waitcnt vmcnt(0)" ::: "memory"); __syncthreads(); if (tid == 0) __hip_atomic_fetch_add(lbw + 64 * 9, 1u, __ATOMIC_RELAXED, __HIP_MEMORY_SCOPE_AGENT); } }
    }
    if (loc) {
        if (IN(3) && IN(4)) xcd_pair_barrier(bar, lbw + 64 * 16);
    } else SEAM(3);
    if (IN(4)) {
        if (loc) {
            const int xcd = cb & 7, j = cb >> 3;
            for (int i = 0; i < 2; ++i) { const int idx = j * 2 + i; attn_unit(xcd >> 1, idx & 7, 8 * (xcd & 1) + (idx >> 3), QB, KB, VB, AC, P.relb, lds); }
        } else if (G == 256) {
            const int xcd = cb & 7, j = cb >> 3;
            for (int i = 0; i < 2; ++i) { const int idx = j * 2 + i, bh = xcd * 4 + (idx >> 4), grp = idx & 15; attn_unit(bh >> 3, bh & 7, grp, QB, KB, VB, AC, P.relb, lds); }
        } else {
            for (int u = cb; u < 512; u += G) { const int bh = u >> 4, grp = u & 15; attn_unit(bh >> 3, bh & 7, grp, QB, KB, VB, AC, P.relb, lds); }
        }
    }
    if (IN(5)) {
        if (loc) conv_unit(32 * (cb & 7) + (cb >> 3), GB, P.dwk, P.dwb, P.lng, P.lnb, AC, lds);
        else for (int u = cb; u < M / 64; u += G) conv_unit(u, GB, P.dwk, P.dwb, P.lng, P.lnb, AC, lds);
    }
    if (loc && IN(5) && IN(6) && tid == 0) { XB_SPIN(xb_ld(lbw + 64 * 9) < 128u, bar.bar); }
    LSEAM(5);
    if (loc && IN(5) && IN(6) && tid == 0) xb_add(lbw + 64 * 10, 1u);
    if (IN(6)) {
        pg8::Gemm g{AC, (const bf16*)(ws + WS_WOUT), M, D, D}; pg8::StaticOrder S; S.init(M, D, G, cb);
        pg8::EpiResidW<true> E{XB, XB, ssq2, 1.0f};
        pg8::gemm_phase<pg8::EpiResidW<true>, pg8::StaticOrder, true, true>(lds, g, S, E);
    }
    LSEAM(6);
    if (IN(7)) {
        pg8::Gemm g{XB, (const bf16*)(ws + WS_WGU2), M, 2 * FF, D}; pg8::StaticOrder S; S.init(M, 2 * FF, G, cb, true);
        pg8::EpiProj<0> E{nullptr, 512, 0, 1.f, 0, HB, FF, ssq2, (LAS float*)(lds + LDS_RTAB)};
        pg8::gemm_phase<pg8::EpiProj<0>, pg8::StaticOrder, true, true>(lds, g, S, E);
    }
    if (loc && IN(7) && IN(8) && tid == 0) { XB_SPIN(xb_ld(lbw + 64 * 10) < (unsigned)G, bar.bar); }
    LSEAM(7);
    if (IN(8)) {
        pg8::Gemm g{HB, (const bf16*)(ws + WS_WD2), M, D, FF}; pg8::StaticOrder S; S.init(M, D, G, cb);
        if (G == 256) {
            pg8::EpiFinal E{XB, P.out, ssq3, (unsigned*)ws, P.nf, 0.5f, (LAS float*)(lds + LDS_RTAB)};
            pg8::gemm_phase<pg8::EpiFinal, pg8::StaticOrder, true, true>(lds, g, S, E);
        } else {
            pg8::EpiResid<true, true> E{XB, P.out, nullptr, ssq3, 0.5f};
            pg8::gemm_phase<pg8::EpiResid<true, true>, pg8::StaticOrder, true, true>(lds, g, S, E);
        }
    }
    if (G != 256) SEAM(8);
    if (IN(9) && G != 256) {
        const int gw = vcu * NWAVES + wave, NGW = G * NWAVES;
        f32x4 gv[4];
#pragma unroll
        for (int j = 0; j < 4; ++j) gv[j] = ((const f32x4*)P.nf)[lane + 64 * j];
        for (int m = gw; m < M; m += 2 * NGW) {
            const int m1 = (m + NGW < M) ? m + NGW : m;
            const float rs0 = pg8::row_rstd(ssq3, m), rs1 = pg8::row_rstd(ssq3, m1);
            f32x4* xr0 = (f32x4*)(P.out + (size_t)m * D) + lane; f32x4* xr1 = (f32x4*)(P.out + (size_t)m1 * D) + lane;
            f32x4 v0[4], v1[4];
#pragma unroll
            for (int j = 0; j < 4; ++j) { v0[j] = xr0[64 * j]; v1[j] = xr1[64 * j]; }
#pragma unroll
            for (int j = 0; j < 4; ++j) { xr0[64 * j] = v0[j] * rs0 * gv[j]; if (m1 != m) xr1[64 * j] = v1[j] * rs1 * gv[j]; }
        }
    }
#undef IN
#undef SEAM
}

#ifndef N_LAUNCH_SPLIT
#define N_LAUNCH_SPLIT 0
#endif

extern "C" void kernel_launch(void* const* d_in, const int* in_sizes, int n_in, void* d_out, int out_size, void* d_ws, size_t ws_size, hipStream_t stream) {
    static int grid = 0;
    if (grid == 0) {
        int dev = 0, cus = 0, per_cu = 0;
        if (n_in != 18 || out_size != M * D || ws_size < WS_END) { fprintf(stderr, "kernel_launch: unexpected shapes (n_in %d out %d ws %zu)\n", n_in, out_size, ws_size); grid = -1; return; }
        hipGetDevice(&dev); hipDeviceGetAttribute(&cus, hipDeviceAttributeMultiprocessorCount, dev);
        if (hipFuncSetAttribute((const void*)fwd_kernel, hipFuncAttributeMaxDynamicSharedMemorySize, LDS_BYTES) != hipSuccess) { fprintf(stderr, "kernel_launch: hipFuncSetAttribute failed\n"); grid = -1; return; }
        if (hipOccupancyMaxActiveBlocksPerMultiprocessor(&per_cu, (const void*)fwd_kernel, NWAVES * 64, LDS_BYTES) != hipSuccess || per_cu < 1) { fprintf(stderr, "kernel_launch: occupancy query says %d\n", per_cu); per_cu = 1; }
        (void)hipGetLastError();
        grid = cus * per_cu;
    }
    if (grid < 0) return;
    if (hipMemsetAsync(d_ws, 0, CTL_ZERO_BYTES, stream) != hipSuccess) { fprintf(stderr, "kernel_launch: memset of the control words failed\n"); return; }
    Args a{};
    for (int i = 0; i < 18; ++i) a.in[i] = (const float*)d_in[i];
    a.out = (float*)d_out; a.ws = (unsigned char*)d_ws;
#if N_LAUNCH_SPLIT
    for (int p = 0; p < 10; ++p) { a.lo = p; a.hi = p + 1; hipLaunchKernelGGL(fwd_kernel, dim3(grid), dim3(NWAVES * 64), LDS_BYTES, stream, a); }
#else
    a.lo = 0; a.hi = 10;
    void* args[] = {&a};
    hipError_t e = hipLaunchCooperativeKernel((const void*)fwd_kernel, dim3(grid), dim3(NWAVES * 64), args, LDS_BYTES, stream);
    if (e != hipSuccess) fprintf(stderr, "cooperative launch failed: %s (grid %d)\n", hipGetErrorString(e), grid);
#endif
}
```
